# Optimizing an MI355X kernel written in HIP

```python
import math
import jax, jax.numpy as jnp
from jax import lax
import numpy as np

D_MODEL = 2048
BATCH = 4
SEQ = 8192
DEPTH = 1

BLOCK = 128
WINDOW = 128
A_HEADS = 8
A_HEAD_DIM = 128
A_WIDTH = A_HEADS * A_HEAD_DIM
B_HEADS = 16
B_KV_HEADS = 2
HEAD_DIM = 64
B_WIDTH = B_HEADS * HEAD_DIM
KV_WIDTH = B_KV_HEADS * HEAD_DIM
MIX_WIDTH = A_WIDTH + B_WIDTH
IN_COLS = 2 * A_WIDTH + B_WIDTH + 2 * KV_WIDTH
D_FF = 5632
N_BUCKETS = 32
MAX_DISTANCE = 128
N_MOD = 9
EPS = 1e-6

kernel_name = "hybrid_gmlp_swa_macaron_adaln_layer"


def rms_norm(x, g):
    xf = x.astype(jnp.float32)
    y = xf * lax.rsqrt(jnp.mean(xf * xf, axis=-1, keepdims=True) + EPS)
    return (y * g.astype(jnp.float32)).astype(x.dtype)


def modulate(h, shift, scale):
    return h * (1 + scale[:, None, :]) + shift[:, None, :]


def swiglu(h, w1, w3, w2):
    return (jax.nn.silu(h @ w1) * (h @ w3)) @ w2


def t5_bucket(n):
    max_exact = N_BUCKETS // 2
    nf = jnp.maximum(n, 1).astype(jnp.float32)
    large = max_exact + (jnp.log(nf / max_exact) / math.log(MAX_DISTANCE / max_exact)
                         * (N_BUCKETS - max_exact)).astype(jnp.int32)
    large = jnp.minimum(large, N_BUCKETS - 1)
    return jnp.where(n < max_exact, n, large)


def gmlp_mixer(u, v, spatial_w, spatial_b, g_v):
    bsz, seq, _ = u.shape
    nb = seq // BLOCK
    u = u.reshape(bsz, nb, BLOCK, A_HEADS, A_HEAD_DIM)
    v = rms_norm(v.reshape(bsz, nb, BLOCK, A_HEADS, A_HEAD_DIM), g_v)
    causal = jnp.tril(jnp.ones((BLOCK, BLOCK), dtype=bool))
    w = jnp.where(causal[None], spatial_w, 0)
    mixed = jnp.einsum('hij,bnjhd->bnihd', w, v) + spatial_b.T[None, None, :, :, None]
    return (u * mixed).reshape(bsz, seq, A_WIDTH)


def swa_mixer(q, k, v, g_q, g_k, sinks, rel_bias):
    bsz, seq, _ = q.shape
    nb = seq // BLOCK
    grp = B_HEADS // B_KV_HEADS
    q = rms_norm(q.reshape(bsz, seq, B_HEADS, HEAD_DIM), g_q)
    k = rms_norm(k.reshape(bsz, seq, B_KV_HEADS, HEAD_DIM), g_k)
    q = q.reshape(bsz, nb, BLOCK, B_KV_HEADS, grp, HEAD_DIM)
    k = k.reshape(bsz, nb, BLOCK, B_KV_HEADS, HEAD_DIM)
    v = v.reshape(bsz, nb, BLOCK, B_KV_HEADS, HEAD_DIM)

    def band(t):
        prev = jnp.pad(t[:, :-1], ((0, 0), (1, 0), (0, 0), (0, 0), (0, 0)))
        return jnp.concatenate([prev, t], axis=2)

    kb, vb = band(k), band(v)
    s = jnp.einsum('bnikgd,bnjkd->bnkgij', q, kb).astype(jnp.float32) * (HEAD_DIM ** -0.5)

    qi = jnp.arange(BLOCK)[:, None]
    kj = jnp.arange(2 * BLOCK)[None, :]
    dist = qi + BLOCK - kj
    in_window = (dist >= 0) & (dist < WINDOW)
    bucket = t5_bucket(jnp.clip(dist, 0, None))
    bias = jnp.transpose(rel_bias[bucket], (2, 0, 1)).astype(jnp.float32)
    bias = bias.reshape(B_KV_HEADS, grp, BLOCK, 2 * BLOCK)
    key_pos = jnp.arange(nb)[:, None] * BLOCK - BLOCK + kj
    valid = in_window[None] & (key_pos >= 0)[:, None, :]

    s = jnp.where(valid[None, :, None, None], s + bias, -jnp.inf)
    sink = sinks.astype(jnp.float32).reshape(B_KV_HEADS, grp)[:, :, None, None]
    m = jnp.maximum(jnp.max(s, axis=-1, keepdims=True), sink)
    p = jnp.exp(s - m)
    w = p / (jnp.sum(p, axis=-1, keepdims=True) + jnp.exp(sink - m))
    o = jnp.einsum('bnkgij,bnjkd->bnikgd', w.astype(vb.dtype), vb)
    return o.reshape(bsz, seq, B_WIDTH)


def setup_inputs(seed: int = 0) -> dict:
    key = jax.random.key(seed)
    ks = jax.random.split(key, 24)
    f32 = jnp.float32
    nrm = lambda k, shape, s: jax.random.normal(k, shape, f32) * s
    gain = lambda k, shape: 1.0 + 0.02 * jax.random.normal(k, shape, f32)
    L, D = DEPTH, D_MODEL
    return {
        "x": nrm(ks[0], (BATCH, SEQ, D), 1.0),
        "c": nrm(ks[1], (BATCH, D), 1.0),
        "w_ada": nrm(ks[2], (L, D, N_MOD * D), 0.5 * D ** -0.5),
        "b_ada": nrm(ks[3], (L, N_MOD * D), 0.01),
        "g_ffn1": gain(ks[4], (L, D)),
        "w1_ffn1": nrm(ks[5], (L, D, D_FF), D ** -0.5),
        "w3_ffn1": nrm(ks[6], (L, D, D_FF), D ** -0.5),
        "w2_ffn1": nrm(ks[7], (L, D_FF, D), D_FF ** -0.5),
        "g_mix": gain(ks[8], (L, D)),
        "w_in": nrm(ks[9], (L, D, IN_COLS), D ** -0.5),
        "spatial_w": nrm(ks[10], (L, A_HEADS, BLOCK, BLOCK), BLOCK ** -0.5),
        "spatial_b": 1.0 + nrm(ks[11], (L, A_HEADS, BLOCK), 0.01),
        "g_v": gain(ks[12], (L, A_HEADS, A_HEAD_DIM)),
        "g_q": gain(ks[13], (L, HEAD_DIM)),
        "g_k": gain(ks[14], (L, HEAD_DIM)),
        "sinks": nrm(ks[15], (L, B_HEADS), 1.0),
        "rel_bias": nrm(ks[16], (N_BUCKETS, B_HEADS), 0.5),
        "w_out": nrm(ks[17], (L, MIX_WIDTH, D), MIX_WIDTH ** -0.5),
        "g_ffn2": gain(ks[18], (L, D)),
        "w1_ffn2": nrm(ks[19], (L, D, D_FF), D ** -0.5),
        "w3_ffn2": nrm(ks[20], (L, D, D_FF), D ** -0.5),
        "w2_ffn2": nrm(ks[21], (L, D_FF, D), D_FF ** -0.5),
    }


def reference(x, c, w_ada, b_ada, g_ffn1, w1_ffn1, w3_ffn1, w2_ffn1, g_mix, w_in,
              spatial_w, spatial_b, g_v, g_q, g_k, sinks, rel_bias, w_out,
              g_ffn2, w1_ffn2, w3_ffn2, w2_ffn2):
    c_act = jax.nn.silu(c)
    split_pts = [A_WIDTH, 2 * A_WIDTH, 2 * A_WIDTH + B_WIDTH, 2 * A_WIDTH + B_WIDTH + KV_WIDTH]
    for l in range(DEPTH):
        mod = c_act @ w_ada[l] + b_ada[l]
        sh1, sc1, gt1, sh2, sc2, gt2, sh3, sc3, gt3 = jnp.split(mod, N_MOD, axis=-1)

        h = modulate(rms_norm(x, g_ffn1[l]), sh1, sc1)
        x = x + 0.5 * gt1[:, None, :] * swiglu(h, w1_ffn1[l], w3_ffn1[l], w2_ffn1[l])

        h = modulate(rms_norm(x, g_mix[l]), sh2, sc2)
        z = h @ w_in[l]
        za_u, za_v, zq, zk, zv = jnp.split(z, split_pts, axis=-1)
        ya = gmlp_mixer(jax.nn.gelu(za_u, approximate=False), jax.nn.gelu(za_v, approximate=False),
                        spatial_w[l], spatial_b[l], g_v[l])
        yb = swa_mixer(zq, zk, zv, g_q[l], g_k[l], sinks[l], rel_bias)
        y = jnp.concatenate([ya, yb], axis=-1) @ w_out[l]
        x = x + gt2[:, None, :] * y

        h = modulate(rms_norm(x, g_ffn2[l]), sh3, sc3)
        x = x + 0.5 * gt3[:, None, :] * swiglu(h, w1_ffn2[l], w3_ffn2[l], w2_ffn2[l])
    return x
```

```cpp
#include <hip/hip_runtime.h>
#include <hip/hip_cooperative_groups.h>
#include <cstdio>
#include <cstdint>
namespace cg = cooperative_groups;

#ifndef MK_SCHED
#define MK_SCHED 0, 1, 2, 3, 4, 6, 7, 8, 10, 11
#endif
#ifndef MK_EPI_REP_UP
#define MK_EPI_REP_UP 1
#endif
#ifndef MK_EPI_REP_OUT
#define MK_EPI_REP_OUT 1
#endif
#ifndef MK_SYNC_REPEAT
#define MK_SYNC_REPEAT 1
#endif
#ifndef MK_PER_PHASE
#define MK_PER_PHASE 0
#endif

namespace pg8 {
#define PG8_LAS __attribute__((address_space(3)))
typedef unsigned short bf16_t;
typedef short bf16x8 __attribute__((ext_vector_type(8)));
typedef float f32x4 __attribute__((ext_vector_type(4)));
typedef float f32x2 __attribute__((ext_vector_type(2)));
typedef unsigned u32x4 __attribute__((ext_vector_type(4)));
typedef unsigned u32x2 __attribute__((ext_vector_type(2)));
constexpr int BM = 256, BK = 64, HALF = 128, HTB = HALF * BK * 2, STAGE_BYTES = 8 * HTB, NXCD = 8, WGM = 4;
constexpr int EPI_LDS_OFF = STAGE_BYTES + 1024;

__host__ __device__ __forceinline__ int lds_byte(int r, int c) { const int st = (r >> 4) * 2 + (c >> 5), rr = r & 15, cc = c & 31, ob = rr * 64 + cc * 2; return st * 1024 + (ob ^ (((ob >> 9) & 1) << 5)); }
__host__ __device__ __forceinline__ void stage_rc(int b, int& R, int& C) { const int st = b / 1024, sb = b % 1024, swz = sb ^ (((sb >> 9) & 1) << 5); R = (st >> 1) * 16 + swz / 64; C = (st & 1) * 32 + (swz % 64) / 2; }
__host__ __device__ __forceinline__ int perm32(int rho) { const int n = rho >> 4, i = rho & 15; return 8 * (i >> 2) + 4 * n + (i & 3); }

struct Unit { int pm, pn; };
struct Gemm { const bf16_t* A; const bf16_t* Bt; int M, N, K; };

struct StaticOrder {
    int nM, nN, nwg, G, c;
    __host__ __device__ void init(int M, int N, int G_, int c_) { nM = M / BM; nN = N / BM; nwg = nM * nN; G = G_; c = c_; }
    __host__ __device__ bool next(int i, Unit& u) const {
        const long L = (long)i * G + c; if (L >= nwg) return false;
        int wgid = (int)L; { const int q = nwg / NXCD, r = nwg % NXCD, xcd = wgid % NXCD, off = wgid / NXCD; wgid = (xcd < r ? xcd * (q + 1) : r * (q + 1) + (xcd - r) * q) + off; }
        const int nig = WGM * nN, gid = wgid / nig, fm = gid * WGM, gsz = (nM - fm) < WGM ? (nM - fm) : WGM;
        u.pm = fm + ((wgid % nig) % gsz); u.pn = (wgid % nig) / gsz; return true;
    }
    __device__ __forceinline__ void a_ready(const Unit&) const {}
    __device__ __forceinline__ void done(const Unit&) const {}
};

__device__ __forceinline__ unsigned cvt_pk_bf16(float lo, float hi) { unsigned r; asm volatile("v_cvt_pk_bf16_f32 %0, %1, %2" : "=v"(r) : "v"(lo), "v"(hi)); return r; }
__device__ __forceinline__ f32x2 gelu_pk(f32x2 v) {
    const f32x2 av = __builtin_elementwise_abs(v), d = av * 0.2316418882f + 1.0f;
    f32x2 t; t.x = __builtin_amdgcn_rcpf(d.x); t.y = __builtin_amdgcn_rcpf(d.y);
    f32x2 q = t * 0.5307027145f + (-0.7265760135f); q = q * t + 0.7107068705f; q = q * t + (-0.142248368f); q = q * t + 0.127414796f; q = q * t;
    const f32x2 s = (v * v) * (-0.72134752044f);
    f32x2 e; e.x = __builtin_amdgcn_exp2f(s.x); e.y = __builtin_amdgcn_exp2f(s.y);
    const f32x2 m = v * (q * e), r = v - m;
    f32x2 o; o.x = v.x < 0.f ? m.x : r.x; o.y = v.y < 0.f ? m.y : r.y; return o;
}
__device__ __forceinline__ f32x2 silu_mul_pk(f32x2 a, f32x2 b) {
    const f32x2 t = a * (-1.4426950408889634f); f32x2 e; e.x = __builtin_amdgcn_exp2f(t.x); e.y = __builtin_amdgcn_exp2f(t.y);
    const f32x2 d = e + 1.0f; f32x2 r; r.x = __builtin_amdgcn_rcpf(d.x); r.y = __builtin_amdgcn_rcpf(d.y);
    return (a * b) * r;
}
__device__ __forceinline__ float silu_f(float a) { return a * __builtin_amdgcn_rcpf(1.0f + __builtin_amdgcn_exp2f(a * -1.4426950408889634f)); }


struct EpiSwiGLU {
    static constexpr bool PERM = true, AFTER_DRAIN = false; static constexpr int REP = MK_EPI_REP_UP;
    bf16_t* O; int ldc; const float* ssq; const float* bias2; int bias_stride; int tiles_per_batch;
    __device__ __forceinline__ void prefetch(PG8_LAS unsigned char* sl, const Unit& u, int wr, int wc, int lane) const {
        const float* sp = ssq + u.pm * BM + wr * 64 + lane;
        __builtin_amdgcn_global_load_lds((const unsigned*)sp, (PG8_LAS unsigned*)sl, 4, 0, 0);
        __builtin_amdgcn_global_load_lds((const unsigned*)(sp + HALF), (PG8_LAS unsigned*)(sl + 256), 4, 0, 0);
        const float* bp = bias2 + (size_t)(u.pm / tiles_per_batch) * bias_stride + u.pn * BM + wc * 32 + (lane & 31) + (lane >> 5) * HALF;
        __builtin_amdgcn_global_load_lds((const unsigned*)bp, (PG8_LAS unsigned*)(sl + 512), 4, 0, 0);
    }
    __device__ __forceinline__ void operator()(const f32x4 (&acc)[2][2][4][2], const Unit& u, int wr, int wc, int fr, int fq, PG8_LAS unsigned char* sl) const {
        const int row0 = u.pm * BM + wr * 64 + fr, col0 = u.pn * HALF + wc * 32 + 8 * fq;
        const PG8_LAS float* sf = (const PG8_LAS float*)sl;
        f32x4 bw[2][2];
#pragma unroll
        for (int bj = 0; bj < 2; ++bj)
#pragma unroll
            for (int n = 0; n < 2; ++n) bw[bj][n] = *(const PG8_LAS f32x4*)(sf + 128 + bj * 32 + 8 * fq + 4 * n);
#pragma unroll
        for (int ai = 0; ai < 2; ++ai)
#pragma unroll
            for (int m = 0; m < 4; ++m) { const int row = row0 + ai * HALF + m * 16; bf16_t* rowp = O + (size_t)row * ldc + col0;
                const float rs = __builtin_amdgcn_rsqf(sf[ai * 64 + m * 16 + fr] * (1.0f / 2048.0f) + 1e-6f);
                const f32x4 a0 = acc[ai][0][m][0] * rs + bw[0][0], a1 = acc[ai][0][m][1] * rs + bw[0][1], b0 = acc[ai][1][m][0] * rs + bw[1][0], b1 = acc[ai][1][m][1] * rs + bw[1][1];
                const f32x2 s0 = silu_mul_pk((f32x2){a0[0], a0[1]}, (f32x2){b0[0], b0[1]}), s1 = silu_mul_pk((f32x2){a0[2], a0[3]}, (f32x2){b0[2], b0[3]});
                const f32x2 s2 = silu_mul_pk((f32x2){a1[0], a1[1]}, (f32x2){b1[0], b1[1]}), s3 = silu_mul_pk((f32x2){a1[2], a1[3]}, (f32x2){b1[2], b1[3]});
                u32x4 w; w.x = cvt_pk_bf16(s0.x, s0.y); w.y = cvt_pk_bf16(s1.x, s1.y); w.z = cvt_pk_bf16(s2.x, s2.y); w.w = cvt_pk_bf16(s3.x, s3.y);
                *(u32x4*)rowp = w; }
    }
};
struct EpiZ {
    static constexpr bool PERM = true, AFTER_DRAIN = false; static constexpr int REP = 1;
    bf16_t* O; int ldc; int gelu_tiles; const float* ssq; const float* bias2; int bias_stride; int tiles_per_batch;
    __device__ __forceinline__ void prefetch(PG8_LAS unsigned char* sl, const Unit& u, int wr, int wc, int lane) const {
        const float* sp = ssq + u.pm * BM + wr * 64 + lane;
        __builtin_amdgcn_global_load_lds((const unsigned*)sp, (PG8_LAS unsigned*)sl, 4, 0, 0);
        __builtin_amdgcn_global_load_lds((const unsigned*)(sp + HALF), (PG8_LAS unsigned*)(sl + 256), 4, 0, 0);
        const float* bp = bias2 + (size_t)(u.pm / tiles_per_batch) * bias_stride + u.pn * BM + wc * 32 + (lane & 31) + (lane >> 5) * HALF;
        __builtin_amdgcn_global_load_lds((const unsigned*)bp, (PG8_LAS unsigned*)(sl + 512), 4, 0, 0);
    }
    __device__ __forceinline__ void operator()(const f32x4 (&acc)[2][2][4][2], const Unit& u, int wr, int wc, int fr, int fq, PG8_LAS unsigned char* sl) const {
        const int row0 = u.pm * BM + wr * 64 + fr, col0 = u.pn * BM + wc * 32 + 8 * fq;
        const bool act = u.pn < gelu_tiles;
        const PG8_LAS float* sf = (const PG8_LAS float*)sl;
        f32x4 bw[2][2];
#pragma unroll
        for (int bj = 0; bj < 2; ++bj)
#pragma unroll
            for (int n = 0; n < 2; ++n) bw[bj][n] = *(const PG8_LAS f32x4*)(sf + 128 + bj * 32 + 8 * fq + 4 * n);
#pragma unroll
        for (int ai = 0; ai < 2; ++ai)
#pragma unroll
            for (int m = 0; m < 4; ++m) { const int row = row0 + ai * HALF + m * 16; bf16_t* rowp = O + (size_t)row * ldc + col0;
                const float rs = __builtin_amdgcn_rsqf(sf[ai * 64 + m * 16 + fr] * (1.0f / 2048.0f) + 1e-6f);
#pragma unroll
                for (int bj = 0; bj < 2; ++bj) { f32x4 v0 = acc[ai][bj][m][0] * rs + bw[bj][0], v1 = acc[ai][bj][m][1] * rs + bw[bj][1];
                    if (act) { f32x2 a = gelu_pk((f32x2){v0[0], v0[1]}), b = gelu_pk((f32x2){v0[2], v0[3]}), c = gelu_pk((f32x2){v1[0], v1[1]}), d = gelu_pk((f32x2){v1[2], v1[3]});
                        v0 = (f32x4){a.x, a.y, b.x, b.y}; v1 = (f32x4){c.x, c.y, d.x, d.y}; }
                    u32x4 w; w.x = cvt_pk_bf16(v0[0], v0[1]); w.y = cvt_pk_bf16(v0[2], v0[3]); w.z = cvt_pk_bf16(v1[0], v1[1]); w.w = cvt_pk_bf16(v1[2], v1[3]);
                    *(u32x4*)(rowp + bj * HALF) = w; } }
    }
};

template <class Epi, class Sched, bool ALIGN_EPI = false, bool SP2 = false>
__device__ __forceinline__ void gemm_phase(PG8_LAS unsigned char* lds, const Gemm g, const Sched& S, const Epi& E, const int tid) {
    const int wid = __builtin_amdgcn_readfirstlane(tid >> 6), lane = tid & 63, wr = wid >> 2, wc = wid & 3, fr = lane & 15, fq = lane >> 4;
    const int K = g.K, nt = K / BK;
    unsigned voffA[2], voffB[2];
#pragma unroll
    for (int i = 0; i < 2; ++i) { int R, C; stage_rc(tid * 16 + i * 8192, R, C); const int Rb = Epi::PERM ? ((R & ~31) + perm32(R & 31)) : R;
        voffA[i] = (unsigned)(R * K + C) * 2u; voffB[i] = (unsigned)(Rb * K + C) * 2u; }
    const size_t kstep = (size_t)(BK * 2);
    const size_t hstep = (size_t)HALF * K * 2;
    const size_t tstep = 2 * hstep;
    const unsigned ldsw = (unsigned)wid * 1024u;
    const int aoff = lds_byte(wr * 64 + fr, fq * 8), boff = lds_byte(wc * 32 + fr, fq * 8);
#define PG8_SA(b, h) (((b) * 2 + (h)) * HTB)
#define PG8_SB(b, h) ((4 + (b) * 2 + (h)) * HTB)
#define PG8_STAGE(bufoff, gbase, voff) do { _Pragma("unroll") for (int _i = 0; _i < 2; ++_i) \
        __builtin_amdgcn_global_load_lds((const unsigned*)((const char*)(gbase) + (voff)[_i]), (PG8_LAS unsigned*)(lds + (bufoff) + ldsw + _i * 8192), 16, 0, 0); } while (0)
#define PG8_LDA(dst, b, h) do { _Pragma("unroll") for (int m = 0; m < 4; ++m) _Pragma("unroll") for (int k = 0; k < 2; ++k) dst[m][k] = *(const PG8_LAS bf16x8*)(lds + PG8_SA(b, h) + aoff + m * 2048 + k * 1024); } while (0)
#define PG8_LDB(dst, b, h) do { _Pragma("unroll") for (int n = 0; n < 2; ++n) _Pragma("unroll") for (int k = 0; k < 2; ++k) dst[n][k] = *(const PG8_LAS bf16x8*)(lds + PG8_SB(b, h) + boff + n * 2048 + k * 1024); } while (0)
#define PG8_MMA(ai, bj, At, Bt) do { __builtin_amdgcn_s_setprio(1); _Pragma("unroll") for (int m = 0; m < 4; ++m) _Pragma("unroll") for (int n = 0; n < 2; ++n) _Pragma("unroll") for (int k = 0; k < 2; ++k) \
        acc[ai][bj][m][n] = __builtin_amdgcn_mfma_f32_16x16x32_bf16(Bt[n][k], At[m][k], acc[ai][bj][m][n], 0, 0, 0); __builtin_amdgcn_s_setprio(0); } while (0)
#define PG8_WAIT_V(n) asm volatile("s_waitcnt vmcnt(" #n ")" ::: "memory")
#define PG8_WAIT_L(n) asm volatile("s_waitcnt lgkmcnt(" #n ")" ::: "memory")
#define PG8_BAR __builtin_amdgcn_s_barrier()
#define PG8_SCHED __builtin_amdgcn_sched_barrier(0)
    Unit cur, nxt; int ui = 0;
    if (!S.next(0, cur)) return;
    f32x4 acc[2][2][4][2];
#pragma unroll
    for (int a = 0; a < 2; ++a)
#pragma unroll
        for (int b = 0; b < 2; ++b)
#pragma unroll
            for (int m = 0; m < 4; ++m)
#pragma unroll
                for (int n = 0; n < 2; ++n) acc[a][b][m][n] = (f32x4){0.f, 0.f, 0.f, 0.f};
    bf16x8 At[4][2], B0[2][2], B1[2][2];
    const char* cA = (const char*)g.A + (size_t)cur.pm * tstep; const char* cB = (const char*)g.Bt + (size_t)cur.pn * tstep;
    S.a_ready(cur);
    if constexpr (SP2) {
        PG8_STAGE(PG8_SB(0, 0), cB, voffB); PG8_STAGE(PG8_SB(0, 1), cB + hstep, voffB); PG8_STAGE(PG8_SA(0, 0), cA, voffA); PG8_STAGE(PG8_SA(0, 1), cA + hstep, voffA);
        if (wr == 1) PG8_BAR;
        PG8_WAIT_V(2); PG8_BAR;
        PG8_STAGE(PG8_SB(1, 0), cB + kstep, voffB); PG8_STAGE(PG8_SA(1, 0), cA + kstep, voffA); PG8_STAGE(PG8_SB(1, 1), cB + hstep + kstep, voffB);
        PG8_WAIT_V(6); PG8_BAR;
    } else {
        PG8_STAGE(PG8_SB(0, 0), cB, voffB); PG8_STAGE(PG8_SA(0, 0), cA, voffA); PG8_STAGE(PG8_SB(0, 1), cB + hstep, voffB); PG8_STAGE(PG8_SA(0, 1), cA + hstep, voffA);
        if (wr == 1) PG8_BAR;
        PG8_WAIT_V(4); PG8_BAR;
        PG8_STAGE(PG8_SB(1, 0), cB + kstep, voffB); PG8_STAGE(PG8_SA(1, 0), cA + kstep, voffA); PG8_STAGE(PG8_SB(1, 1), cB + hstep + kstep, voffB);
        PG8_WAIT_V(6); PG8_BAR;
    }
    for (;;) {
        const bool has_next = S.next(ui + 1, nxt);
        const char* nA = has_next ? (const char*)g.A + (size_t)nxt.pm * tstep : cA; const char* nB = has_next ? (const char*)g.Bt + (size_t)nxt.pn * tstep : cB;
        for (int t = 0; t < nt; t += 2) {
            const bool last = (t == nt - 2);
            const char* a1 = cA + (size_t)(t + 1) * kstep;
            const char* a2 = last ? nA : cA + (size_t)(t + 2) * kstep; const char* b2 = last ? nB : cB + (size_t)(t + 2) * kstep;
            const char* a3 = a2 + kstep; const char* b3 = b2 + kstep;
            if (last && has_next) S.a_ready(nxt);
            if (last) E.prefetch(lds + EPI_LDS_OFF + wid * 1024, cur, wr, wc, lane);
            if constexpr (SP2) {
            PG8_LDB(B0, 0, 0); PG8_LDB(B1, 0, 1); PG8_SCHED; PG8_LDA(At, 0, 0); PG8_STAGE(PG8_SA(1, 1), a1 + hstep, voffA);
            PG8_WAIT_V(8); PG8_WAIT_L(0); PG8_BAR; PG8_MMA(0, 0, At, B0); PG8_MMA(0, 1, At, B1); PG8_BAR; PG8_SCHED;
            PG8_LDA(At, 0, 1); PG8_STAGE(PG8_SB(0, 0), b2, voffB); PG8_STAGE(PG8_SB(0, 1), b2 + hstep, voffB); PG8_STAGE(PG8_SA(0, 0), a2, voffA);
            PG8_WAIT_V(8); PG8_WAIT_L(0); PG8_BAR; PG8_MMA(1, 0, At, B0); PG8_MMA(1, 1, At, B1); PG8_BAR; PG8_SCHED;
            PG8_LDB(B0, 1, 0); PG8_LDB(B1, 1, 1); PG8_SCHED; PG8_LDA(At, 1, 0); PG8_STAGE(PG8_SA(0, 1), a2 + hstep, voffA);
            PG8_WAIT_V(8); PG8_WAIT_L(0); PG8_BAR; PG8_MMA(0, 0, At, B0); PG8_MMA(0, 1, At, B1); PG8_BAR; PG8_SCHED;
            PG8_LDA(At, 1, 1); PG8_STAGE(PG8_SB(1, 0), b3, voffB); PG8_STAGE(PG8_SB(1, 1), b3 + hstep, voffB); PG8_STAGE(PG8_SA(1, 0), a3, voffA);
            PG8_WAIT_V(8); PG8_WAIT_L(0); PG8_BAR; PG8_MMA(1, 0, At, B0); PG8_MMA(1, 1, At, B1); PG8_BAR; PG8_SCHED;
            } else {
            PG8_LDB(B0, 0, 0); PG8_SCHED; PG8_LDA(At, 0, 0); PG8_STAGE(PG8_SA(1, 1), a1 + hstep, voffA);
            PG8_WAIT_L(8); PG8_BAR; PG8_WAIT_L(0); PG8_MMA(0, 0, At, B0); PG8_BAR; PG8_SCHED;
            PG8_LDB(B1, 0, 1); PG8_STAGE(PG8_SB(0, 0), b2, voffB);
            PG8_BAR; PG8_WAIT_L(0); PG8_MMA(0, 1, At, B1); PG8_BAR;
            PG8_LDA(At, 0, 1); PG8_STAGE(PG8_SA(0, 0), a2, voffA);
            PG8_BAR; PG8_WAIT_L(0); PG8_MMA(1, 0, At, B0); PG8_BAR; PG8_SCHED;
            PG8_STAGE(PG8_SB(0, 1), b2 + hstep, voffB);
            PG8_WAIT_V(6); PG8_BAR; PG8_MMA(1, 1, At, B1); PG8_BAR;
            PG8_LDB(B0, 1, 0); PG8_SCHED; PG8_LDA(At, 1, 0); PG8_STAGE(PG8_SA(0, 1), a2 + hstep, voffA);
            PG8_WAIT_L(8); PG8_BAR; PG8_WAIT_L(0); PG8_MMA(0, 0, At, B0); PG8_BAR; PG8_SCHED;
            PG8_LDB(B1, 1, 1); PG8_STAGE(PG8_SB(1, 0), b3, voffB);
            PG8_BAR; PG8_WAIT_L(0); PG8_MMA(0, 1, At, B1); PG8_BAR;
            PG8_LDA(At, 1, 1); PG8_STAGE(PG8_SA(1, 0), a3, voffA);
            PG8_BAR; PG8_WAIT_L(0); PG8_MMA(1, 0, At, B0); PG8_BAR; PG8_SCHED;
            PG8_STAGE(PG8_SB(1, 1), b3 + hstep, voffB);
            PG8_WAIT_V(6); PG8_BAR; PG8_MMA(1, 1, At, B1); PG8_BAR;
            }
        }
        if constexpr (ALIGN_EPI) { if (wr == 0) PG8_BAR; }
        for (int er = 0; er < Epi::REP; ++er) { E(acc, cur, wr, wc, fr, fq, lds + EPI_LDS_OFF + wid * 1024); if (Epi::REP > 1) asm volatile("" ::: "memory"); }
        S.done(cur);
        if (!has_next) break;
#pragma unroll
        for (int a = 0; a < 2; ++a)
#pragma unroll
            for (int b = 0; b < 2; ++b)
#pragma unroll
                for (int m = 0; m < 4; ++m)
#pragma unroll
                    for (int n = 0; n < 2; ++n) acc[a][b][m][n] = (f32x4){0.f, 0.f, 0.f, 0.f};
        cur = nxt; cA = nA; cB = nB; ++ui;
        if constexpr (ALIGN_EPI) { if (wr == 1) PG8_BAR; }
    }
    PG8_WAIT_V(0);
    if constexpr (!ALIGN_EPI) { if (wr == 0) PG8_BAR; }
    PG8_BAR;
#undef PG8_SA
#undef PG8_SB
#undef PG8_STAGE
#undef PG8_LDA
#undef PG8_LDB
#undef PG8_MMA
#undef PG8_WAIT_V
#undef PG8_WAIT_L
#undef PG8_BAR
#undef PG8_SCHED
}
}

constexpr int DM = 2048, BATCH = 4, SEQ = 8192, M = BATCH * SEQ;
constexpr int AW = 1024, BW = 1024, KVW = 128, INC = 3328, DFF = 5632, NMOD = 9;
constexpr int MODW = NMOD * DM;
constexpr float EPS = 1e-6f, LOG2E = 1.4426950408889634f;
constexpr int NWAVES = 8, NTHREADS = 512;
constexpr int LDS_BYTES = 131072 + 1024 + 8192;
constexpr int NKC = 64, KCH = DM / NKC;

constexpr size_t MiB = 1u << 20;
constexpr size_t WS_MOD = 0;
constexpr size_t WS_BAR = 512 * 1024;
constexpr size_t WS_PART = 1 * MiB;
constexpr size_t WS_SSQ = 20 * MiB;
constexpr size_t WS_B2 = 21 * MiB;
constexpr size_t WS_W13A = 24 * MiB;
constexpr size_t WS_W2A = 68 * MiB;
constexpr size_t WS_WIN = 90 * MiB;
constexpr size_t WS_WOUT = 103 * MiB;
constexpr size_t WS_W13B = 111 * MiB;
constexpr size_t WS_W2B = 155 * MiB;
constexpr size_t WS_H = 177 * MiB;
constexpr size_t WS_Y = 305 * MiB;
constexpr size_t WS_U = 433 * MiB;
constexpr size_t WS_XH = 785 * MiB;
constexpr size_t WS_END = 913 * MiB;

typedef unsigned short bf16_t;
typedef short bf16x8 __attribute__((ext_vector_type(8)));
typedef short bf16x4 __attribute__((ext_vector_type(4)));
typedef float f32x4 __attribute__((ext_vector_type(4)));
typedef unsigned u32x4 __attribute__((ext_vector_type(4)));
typedef unsigned u32x2 __attribute__((ext_vector_type(2)));
#define LAS __attribute__((address_space(3)))
#define LDS_WAIT() asm volatile("s_waitcnt lgkmcnt(0)" ::: "memory")

__device__ __forceinline__ unsigned f2bf(float f) { unsigned u = __builtin_bit_cast(unsigned, f); return (u + 0x7fffu + ((u >> 16) & 1u)) >> 16; }
__device__ __forceinline__ unsigned pk2(float lo, float hi) { return pg8::cvt_pk_bf16(lo, hi); }
__device__ __forceinline__ float bf2f(unsigned short b) { return __builtin_bit_cast(float, (unsigned)b << 16); }
__device__ __forceinline__ float bflo(unsigned w) { return __builtin_bit_cast(float, w << 16); }
__device__ __forceinline__ float bfhi(unsigned w) { return __builtin_bit_cast(float, w & 0xffff0000u); }
__device__ __forceinline__ float wave_sum(float v) {
#pragma unroll
    for (int o = 1; o < 64; o <<= 1) v += __shfl_xor(v, o);
    return v;
}


#define XB_TMO      128
#define XB_XCNT(j)  (256  + 64 * (j))
#define XB_XSUB(j)  (1280 + 64 * (j))
#define XB_XGEN(j)  (2304 + 64 * (j))
#define XB_TOP      3328
#define XB_TOPGEN   3392
#define XCD_BAR_WORDS 3456
#define XB_SPIN_CAP (1u << 22)
__device__ __forceinline__ unsigned xb_ld(unsigned* p)              { return __hip_atomic_load(p, __ATOMIC_RELAXED, __HIP_MEMORY_SCOPE_AGENT); }
__device__ __forceinline__ unsigned xb_add(unsigned* p, unsigned v) { return __hip_atomic_fetch_add(p, v, __ATOMIC_RELAXED, __HIP_MEMORY_SCOPE_AGENT); }
__device__ __forceinline__ unsigned xb_xcc_id() { return (unsigned)__builtin_amdgcn_s_getreg((3 << 11) | 20) & 0xFu; }
#define XB_SPIN(cond, bar) do { unsigned _sp = 0; while (cond) { __builtin_amdgcn_s_sleep(1); \
    if ((++_sp & 255u) == 0u) { if (xb_ld(&(bar)[XB_TMO])) break; if (_sp > XB_SPIN_CAP) { atomicAdd(&(bar)[XB_TMO], 1u); break; } } } } while (0)
struct XcdBarrier { unsigned* bar; unsigned x; volatile LAS unsigned* st; };
__device__ __forceinline__ XcdBarrier xcd_barrier_post(unsigned* bar, volatile LAS unsigned* st) {
    XcdBarrier b; b.bar = bar; b.x = xb_xcc_id(); b.st = st;
    if (threadIdx.x == 0) (void)xb_add(&bar[XB_XCNT(b.x)], 1u);
    return b;
}
__device__ __forceinline__ void xcd_barrier_complete(unsigned* bar, unsigned x, unsigned& nloc, unsigned& nx) {
    const unsigned G = gridDim.x * gridDim.y * gridDim.z;
    unsigned sum, cnt, mine, sp = 0u;
    for (;;) {
        sum = 0u; cnt = 0u; mine = 0u;
#pragma unroll
        for (unsigned j = 0; j < 16; ++j) { const unsigned c = xb_ld(&bar[XB_XCNT(j)]); sum += c; cnt += (c > 0u) ? 1u : 0u; mine = (j == x) ? c : mine; }
        if (sum == G) break;
        __builtin_amdgcn_s_sleep(1);
        if ((++sp & 255u) == 0u) { if (xb_ld(&bar[XB_TMO])) break; if (sp > XB_SPIN_CAP) { atomicAdd(&bar[XB_TMO], 1u); break; } }
    }
    nloc = mine > 0u ? mine : 1u; nx = cnt > 0u ? cnt : 1u;
}
__device__ __forceinline__ void xcd_barrier(const XcdBarrier& b) {
    asm volatile("s_waitcnt vmcnt(0)" ::: "memory");
    __syncthreads();
    if (threadIdx.x == 0) {
        unsigned* bar = b.bar;
        __builtin_amdgcn_s_waitcnt(0);
        unsigned nloc = b.st[0], nx = b.st[1];
        if (nloc == 0u) { xcd_barrier_complete(bar, b.x, nloc, nx); b.st[0] = nloc; b.st[1] = nx; }
        const unsigned old = xb_add(&bar[XB_XSUB(b.x)], 1u);
        const unsigned gen = old / nloc;
        if (old + 1u == (gen + 1u) * nloc) {
            __builtin_amdgcn_fence(__ATOMIC_RELEASE, "agent");
            asm volatile("s_waitcnt vmcnt(0)" ::: "memory");
            const unsigned og = xb_add(&bar[XB_TOP], 1u);
            const unsigned tg = og / nx;
            if (og + 1u == (tg + 1u) * nx) xb_add(&bar[XB_TOPGEN], 1u);
            else XB_SPIN(xb_ld(&bar[XB_TOPGEN]) == tg, bar);
            __builtin_amdgcn_fence(__ATOMIC_ACQUIRE, "agent");
            xb_add(&bar[XB_XGEN(b.x)], 1u);
            asm volatile("s_waitcnt vmcnt(0)" ::: "memory");
        } else {
            XB_SPIN(xb_ld(&bar[XB_XGEN(b.x)]) == gen, bar);
            __builtin_amdgcn_fence(__ATOMIC_ACQUIRE, "agent");
            asm volatile("s_waitcnt vmcnt(0)" ::: "memory");
        }
    }
    __syncthreads();
}

struct Args { const float* in[22]; float* out; unsigned char* ws; int ph_lo, ph_hi; };
typedef const __attribute__((address_space(4))) Args* KA;
enum { I_X = 0, I_C, I_WADA, I_BADA, I_GF1, I_W1A, I_W3A, I_W2A, I_GMIX, I_WIN, I_SPW, I_SPB, I_GV, I_GQ, I_GK, I_SINKS, I_RELB, I_WOUT, I_GF2, I_W1B, I_W3B, I_W2B };


typedef _Float16 h16x4 __attribute__((ext_vector_type(4)));
typedef _Float16 h16x8 __attribute__((ext_vector_type(8)));
template <int MODE> struct EpiResidK {
    static constexpr bool PERM = true, AFTER_DRAIN = false; static constexpr int REP = (MODE == 2) ? MK_EPI_REP_OUT : 1;
    KA ka;
    __device__ __forceinline__ void prefetch(LAS unsigned char* sl, const pg8::Unit& u, int wr, int wc, int lane) const {
        KA k = ka; asm volatile("" : "+s"(k));
        const float* mod = (const float*)(k->ws + WS_MOD);
        const int col = u.pn * pg8::BM + wc * 32 + (lane & 31) + (lane >> 5) * pg8::HALF; const size_t bo = (size_t)(u.pm / (SEQ / 256)) * MODW;
        const float* gate = mod + (MODE == 0 ? 2 : MODE == 1 ? 5 : 8) * DM + bo + col;
        __builtin_amdgcn_global_load_lds((const unsigned*)gate, (LAS unsigned*)sl, 4, 0, 0);
        if constexpr (MODE != 2) {
            const float* g_next = k->in[MODE == 0 ? I_GMIX : I_GF2] + col; const float* sc_next = mod + (MODE == 0 ? 4 : 7) * DM + bo + col;
            __builtin_amdgcn_global_load_lds((const unsigned*)g_next, (LAS unsigned*)(sl + 256), 4, 0, 0);
            __builtin_amdgcn_global_load_lds((const unsigned*)sc_next, (LAS unsigned*)(sl + 512), 4, 0, 0);
        }
    }
    __device__ __forceinline__ void operator()(const pg8::f32x4 (&acc)[2][2][4][2], const pg8::Unit& u, int wr, int wc, int fr, int fq, LAS unsigned char* sl) const {
        using pg8::BM; using pg8::HALF; using pg8::cvt_pk_bf16;
        KA k = ka; asm volatile("" : "+s"(k));
        unsigned char* ws = k->ws;
        constexpr float scale = (MODE == 1) ? 1.0f : 0.5f;
        constexpr bool has_next = (MODE != 2);
        const float* xin = k->in[I_X]; _Float16* XH = (_Float16*)(ws + WS_XH); float* outf = k->out;
        bf16_t* An = (bf16_t*)(ws + WS_H); float* ssq_next = (float*)(ws + WS_SSQ) + (MODE == 0 ? M : 2 * M);
        constexpr int ldc = DM;
        const int col0 = u.pn * BM + wc * 32 + 8 * fq;
        const int rowb = u.pm * BM + wr * 64 + fr;
        constexpr int WIN = (MODE == 0) ? 2 : 4;
        f32x4 bsf[MODE == 0 ? WIN : 1][2][2]; h16x8 bsh[MODE == 0 ? 1 : WIN][2];
#define RES_LOAD(slot, rowidx) do { const size_t o_ = (size_t)(rowidx) * ldc + col0; \
        if constexpr (MODE == 0) { _Pragma("unroll") for (int bj = 0; bj < 2; ++bj) _Pragma("unroll") for (int n = 0; n < 2; ++n) bsf[slot][bj][n] = __builtin_nontemporal_load((const f32x4*)(xin + o_ + bj * HALF + n * 4)); } \
        else { _Pragma("unroll") for (int bj = 0; bj < 2; ++bj) bsh[slot][bj] = *(const h16x8*)(XH + o_ + bj * HALF); } } while (0)
#pragma unroll
        for (int gi = 0; gi < WIN; ++gi) RES_LOAD(gi, rowb + (gi >> 2) * HALF + (gi & 3) * 16);
        const LAS float* sf = (const LAS float*)sl;
        f32x4 gv[2][2], ca[2][2];
#pragma unroll
        for (int bj = 0; bj < 2; ++bj)
#pragma unroll
            for (int n = 0; n < 2; ++n) { gv[bj][n] = *(const LAS f32x4*)(sf + bj * 32 + 8 * fq + 4 * n) * scale;
                if constexpr (has_next) ca[bj][n] = *(const LAS f32x4*)(sf + 64 + bj * 32 + 8 * fq + 4 * n) * (*(const LAS f32x4*)(sf + 128 + bj * 32 + 8 * fq + 4 * n) + 1.0f);
                else ca[bj][n] = (f32x4){0.f, 0.f, 0.f, 0.f}; }
#pragma unroll
        for (int gi = 0; gi < 8; ++gi) { const int ai = gi >> 2, m = gi & 3;
            const int row = rowb + ai * HALF + m * 16; const size_t off = (size_t)row * ldc + col0;
            float sq = 0.f;
#pragma unroll
            for (int bj = 0; bj < 2; ++bj) { f32x4 o[2];
#pragma unroll
                for (int n = 0; n < 2; ++n) { f32x4 bv;
                    if constexpr (MODE == 0) bv = bsf[gi % WIN][bj][n];
                    else { const h16x8 hh = bsh[gi % WIN][bj]; bv = (f32x4){(float)hh[4 * n], (float)hh[4 * n + 1], (float)hh[4 * n + 2], (float)hh[4 * n + 3]}; }
                    o[n] = bv + gv[bj][n] * acc[ai][bj][m][n];
                    if constexpr (MODE == 2) *(f32x4*)(outf + off + bj * HALF + n * 4) = o[n];
                    sq += (o[n][0] * o[n][0] + o[n][1] * o[n][1]) + (o[n][2] * o[n][2] + o[n][3] * o[n][3]); }
                if constexpr (has_next) {
                    h16x8 xh;
#pragma unroll
                    for (int e = 0; e < 4; ++e) { xh[e] = (_Float16)o[0][e]; xh[4 + e] = (_Float16)o[1][e]; }
                    *(h16x8*)(XH + off + bj * HALF) = xh;
                    const f32x4 h0 = o[0] * ca[bj][0], h1 = o[1] * ca[bj][1];
                    u32x4 w; w.x = cvt_pk_bf16(h0[0], h0[1]); w.y = cvt_pk_bf16(h0[2], h0[3]); w.z = cvt_pk_bf16(h1[0], h1[1]); w.w = cvt_pk_bf16(h1[2], h1[3]);
                    *(u32x4*)(An + off + bj * HALF) = w; } }
            if constexpr (has_next) { sq += __shfl_xor(sq, 16); sq += __shfl_xor(sq, 32); if (fq == 0) atomicAdd(ssq_next + row, sq); }
            if (gi + WIN < 8) RES_LOAD(gi % WIN, rowb + ((gi + WIN) >> 2) * HALF + ((gi + WIN) & 3) * 16);
            asm volatile("" ::: "memory");
        }
#undef RES_LOAD
    }
};

__device__ __forceinline__ void conv_item(const float* W, int K, int N, bf16_t* WT, int kb, int n0, int dst_row0, LAS float* scr, int lane) {
    const int k0 = 64 * kb;
#pragma unroll 8
    for (int i = 0; i < 32; ++i) { const int kk = 2 * i + (lane >> 5); scr[kk * 33 + (lane & 31)] = __builtin_nontemporal_load(W + (size_t)(k0 + kk) * N + n0 + (lane & 31)); }
    LDS_WAIT(); asm volatile("" ::: "memory");
    const int c = lane & 7;
#pragma unroll
    for (int j = 0; j < 4; ++j) { const int n = (lane >> 3) + 8 * j; const LAS float* s = scr + (8 * c) * 33 + n;
        u32x4 o; o.x = pk2(s[0 * 33], s[1 * 33]); o.y = pk2(s[2 * 33], s[3 * 33]); o.z = pk2(s[4 * 33], s[5 * 33]); o.w = pk2(s[6 * 33], s[7 * 33]);
        *(u32x4*)(WT + (size_t)(dst_row0 + n) * K + k0 + 8 * c) = o; }
    LDS_WAIT(); asm volatile("" ::: "memory");
}
__device__ __forceinline__ void conv_dispatch(KA a, int it, LAS float* scr, int lane) {
    unsigned char* ws = a->ws;
    constexpr int I_FF = (DM / 64) * (DFF / 32);
    constexpr int I_DN = (DFF / 64) * (DM / 32);
    constexpr int I_IN = (DM / 64) * (INC / 32);
    constexpr int I_OUT = (DM / 64) * (DM / 32);
    int r = it;
#define CONV_LAYER(W1I, W3I, W2I, WS13, WS2) { \
        bf16_t* W13 = (bf16_t*)(ws + (WS13)); bf16_t* W2 = (bf16_t*)(ws + (WS2)); \
        if (r < I_FF) { const int nblk = DFF / 32, kb = r / nblk, n0 = (r % nblk) * 32; conv_item(a->in[W1I], DM, DFF, W13, kb, n0, (n0 >> 7) * 256 + (n0 & 127), scr, lane); return; } r -= I_FF; \
        if (r < I_FF) { const int nblk = DFF / 32, kb = r / nblk, n0 = (r % nblk) * 32; conv_item(a->in[W3I], DM, DFF, W13, kb, n0, (n0 >> 7) * 256 + 128 + (n0 & 127), scr, lane); return; } r -= I_FF; \
        if (r < I_DN) { const int nblk = DM / 32, kb = r / nblk, n0 = (r % nblk) * 32; conv_item(a->in[W2I], DFF, DM, W2, kb, n0, n0, scr, lane); return; } r -= I_DN; }
    CONV_LAYER(I_W1A, I_W3A, I_W2A, WS_W13A, WS_W2A)
    CONV_LAYER(I_W1B, I_W3B, I_W2B, WS_W13B, WS_W2B)
#undef CONV_LAYER
    if (r < I_IN) { const int nblk = INC / 32, kb = r / nblk, n0 = (r % nblk) * 32; conv_item(a->in[I_WIN], DM, INC, (bf16_t*)(ws + WS_WIN), kb, n0, n0, scr, lane); return; } r -= I_IN;
    if (r < I_OUT) { const int nblk = DM / 32, kb = r / nblk, n0 = (r % nblk) * 32; conv_item(a->in[I_WOUT], DM, DM, (bf16_t*)(ws + WS_WOUT), kb, n0, n0, scr, lane); return; }
}
constexpr int N_CONV_ITEMS = 6 * 5632 + 3328 + 2048;
constexpr int N_MODCG = MODW / 256;
constexpr int N_MOD_ITEMS = N_MODCG * NKC;

__device__ __forceinline__ void mod_item(KA a, int it, LAS float* scr, int lane) {
    const int cgp = it % N_MODCG, kc = it / N_MODCG, k0 = kc * KCH;
    const float* c = a->in[I_C];
    { const int kk = lane & 31, bh = lane >> 5;
#pragma unroll
      for (int bb = 0; bb < 2; ++bb) { const int b = bh * 2 + bb; const float v = c[b * DM + k0 + kk]; scr[b * 32 + kk] = v / (1.0f + __expf(-v)); } }
    LDS_WAIT(); asm volatile("" ::: "memory");
    const float* wp = a->in[I_WADA] + (size_t)k0 * MODW + cgp * 256 + lane * 4;
    f32x4 acc[4] = {{0.f, 0.f, 0.f, 0.f}, {0.f, 0.f, 0.f, 0.f}, {0.f, 0.f, 0.f, 0.f}, {0.f, 0.f, 0.f, 0.f}};
#pragma unroll 8
    for (int kk = 0; kk < KCH; ++kk) { const f32x4 w = __builtin_nontemporal_load((const f32x4*)(wp + (size_t)kk * MODW));
#pragma unroll
        for (int b = 0; b < 4; ++b) acc[b] += w * scr[b * 32 + kk]; }
    float* part = (float*)(a->ws + WS_PART);
#pragma unroll
    for (int b = 0; b < 4; ++b) *(f32x4*)(part + (size_t)(kc * 4 + b) * MODW + cgp * 256 + lane * 4) = acc[b];
    LDS_WAIT(); asm volatile("" ::: "memory");
}

__device__ __forceinline__ void prologue_pass(const float* X, const float* g, const float* mod, int sc_idx, bf16_t* H, float* ssq, int gw, int ngw, int lane) {
    const int rpw = M / ngw;
    const int row0 = gw * rpw, b = row0 / SEQ;
    const f32x4* g4 = (const f32x4*)g + lane; const f32x4* sc4 = (const f32x4*)(mod + (size_t)b * MODW + sc_idx * DM) + lane;
    f32x4 ca[8];
#pragma unroll
    for (int j = 0; j < 8; ++j) ca[j] = g4[64 * j] * (sc4[64 * j] + 1.0f);
    f32x4 vn[8];
    { const f32x4* xr = (const f32x4*)(X + (size_t)row0 * DM) + lane;
#pragma unroll
      for (int j = 0; j < 8; ++j) vn[j] = __builtin_nontemporal_load(xr + 64 * j); }
    for (int rr = 0; rr < rpw; ++rr) {
        const int row = row0 + rr;
        f32x4 v[8]; float s = 0.f;
#pragma unroll
        for (int j = 0; j < 8; ++j) v[j] = vn[j];
        { const f32x4* xr = (const f32x4*)(X + (size_t)(rr + 1 < rpw ? row + 1 : row) * DM) + lane;
#pragma unroll
          for (int j = 0; j < 8; ++j) vn[j] = __builtin_nontemporal_load(xr + 64 * j); }
#pragma unroll
        for (int j = 0; j < 8; ++j) s += (v[j].x * v[j].x + v[j].y * v[j].y) + (v[j].z * v[j].z + v[j].w * v[j].w);
        u32x2* o8 = (u32x2*)(H + (size_t)row * DM) + lane;
#pragma unroll
        for (int j = 0; j < 8; ++j) { const f32x4 h = v[j] * ca[j]; u32x2 w; w.x = pk2(h.x, h.y); w.y = pk2(h.z, h.w); o8[64 * j] = w; }
        s = wave_sum(s);
        if (lane == 0) ssq[row] = s;
    }
}
__device__ __forceinline__ void bias_gemv(const bf16_t* W, int N, const float* shift, float* out, int gw, int ngw, int lane) {
    f32x4 cb[4][4][2];
#pragma unroll
    for (int b = 0; b < 4; ++b)
#pragma unroll
        for (int j = 0; j < 4; ++j) { const float* p = shift + (size_t)b * MODW + 8 * (lane + 64 * j); cb[b][j][0] = *(const f32x4*)p; cb[b][j][1] = *(const f32x4*)(p + 4); }
    for (int n = gw; n < N; n += 2 * ngw) {
        const int n1 = n + ngw; const bool has1 = n1 < N;
        const u32x4* wp0 = (const u32x4*)(W + (size_t)n * DM) + lane; const u32x4* wp1 = (const u32x4*)(W + (size_t)(has1 ? n1 : n) * DM) + lane;
        u32x4 w[2][4];
#pragma unroll
        for (int j = 0; j < 4; ++j) { w[0][j] = wp0[64 * j]; w[1][j] = wp1[64 * j]; }
#pragma unroll
        for (int rr = 0; rr < 2; ++rr) {
            float acc[4] = {0.f, 0.f, 0.f, 0.f};
#pragma unroll
            for (int j = 0; j < 4; ++j) { const f32x4 w0 = (f32x4){bflo(w[rr][j].x), bfhi(w[rr][j].x), bflo(w[rr][j].y), bfhi(w[rr][j].y)}, w1 = (f32x4){bflo(w[rr][j].z), bfhi(w[rr][j].z), bflo(w[rr][j].w), bfhi(w[rr][j].w)};
#pragma unroll
                for (int b = 0; b < 4; ++b) { const f32x4 p = w0 * cb[b][j][0] + w1 * cb[b][j][1]; acc[b] += (p.x + p.y) + (p.z + p.w); } }
            const int nn = rr ? n1 : n;
#pragma unroll
            for (int b = 0; b < 4; ++b) { const float t = wave_sum(acc[b]); if (lane == 0 && (rr == 0 || has1)) out[(size_t)b * N + nn] = t; }
        }
    }
}

constexpr int GW_STR = 136;
__device__ __forceinline__ void gmlp_phase(KA a, LAS unsigned char* lds, int bid, int tid, int wid, int lane) {
    const int h = bid & 7;
    LAS bf16_t* Wl = (LAS bf16_t*)lds;
    LAS bf16_t* Vt = (LAS bf16_t*)(lds + 128 * GW_STR * 2);
    const bf16_t* Z = (const bf16_t*)(a->ws + WS_U); bf16_t* Y = (bf16_t*)(a->ws + WS_Y);
    const int r = lane & 15, q = lane >> 4;
    { const int i = tid >> 2, qd = tid & 3; const float* src = a->in[I_SPW] + ((size_t)h * 128 + i) * 128 + qd * 32;
#pragma unroll
      for (int k = 0; k < 4; ++k) { const f32x4 x0 = *(const f32x4*)(src + 8 * k), x1 = *(const f32x4*)(src + 8 * k + 4); const int j0 = qd * 32 + 8 * k;
          float e[8] = {x0.x, x0.y, x0.z, x0.w, x1.x, x1.y, x1.z, x1.w};
#pragma unroll
          for (int t = 0; t < 8; ++t) e[t] = (j0 + t <= i) ? e[t] : 0.f;
          u32x4 o; o.x = pk2(e[0], e[1]); o.y = pk2(e[2], e[3]); o.z = pk2(e[4], e[5]); o.w = pk2(e[6], e[7]);
          *(LAS u32x4*)(Wl + i * GW_STR + j0) = o; } }
    const int sj = tid >> 2, sqd = tid & 3;
    const int gi_ = 16 * wid + r; const float sb = a->in[I_SPB][h * 128 + gi_];
    float gvr[32];
#pragma unroll
    for (int e = 0; e < 32; ++e) gvr[e] = a->in[I_GV][h * 128 + sqd * 32 + e];
    u32x4 raw[4]; u32x2 ur[8];
    { const int combo = (bid >> 3); const size_t R0 = (size_t)(combo >> 6) * SEQ + (size_t)(combo & 63) * 128;
      const bf16_t* src = Z + (R0 + sj) * INC + AW + h * 128 + sqd * 32;
#pragma unroll
      for (int k = 0; k < 4; ++k) raw[k] = *(const u32x4*)(src + 8 * k);
      const bf16_t* up = Z + (R0 + gi_) * INC + h * 128 + 4 * q;
#pragma unroll
      for (int dt = 0; dt < 8; ++dt) ur[dt] = *(const u32x2*)(up + 16 * dt); }
    for (int it = 0; it < 8; ++it) {
        const int combo = (bid >> 3) + 32 * it; const size_t R0 = (size_t)(combo >> 6) * SEQ + (size_t)(combo & 63) * 128;
        const int combo1 = (bid >> 3) + 32 * (it < 7 ? it + 1 : it); const size_t R1 = (size_t)(combo1 >> 6) * SEQ + (size_t)(combo1 & 63) * 128;
        __syncthreads();
        { float v[32]; float ss = 0.f;
#pragma unroll
          for (int k = 0; k < 4; ++k) { v[8 * k + 0] = bflo(raw[k].x); v[8 * k + 1] = bfhi(raw[k].x); v[8 * k + 2] = bflo(raw[k].y); v[8 * k + 3] = bfhi(raw[k].y);
              v[8 * k + 4] = bflo(raw[k].z); v[8 * k + 5] = bfhi(raw[k].z); v[8 * k + 6] = bflo(raw[k].w); v[8 * k + 7] = bfhi(raw[k].w); }
          { const bf16_t* src = Z + (R1 + sj) * INC + AW + h * 128 + sqd * 32;
#pragma unroll
            for (int k = 0; k < 4; ++k) raw[k] = *(const u32x4*)(src + 8 * k); }
#pragma unroll
          for (int e = 0; e < 32; ++e) ss += v[e] * v[e];
          ss += __shfl_xor(ss, 1); ss += __shfl_xor(ss, 2);
          const float rstd = 1.0f / sqrtf(ss * (1.0f / 128.0f) + EPS);
#pragma unroll
          for (int e = 0; e < 32; ++e) Vt[(sqd * 32 + e) * GW_STR + sj] = (bf16_t)f2bf(v[e] * rstd * gvr[e]); }
        __syncthreads();
        f32x4 acc[8];
#pragma unroll
        for (int dt = 0; dt < 8; ++dt) acc[dt] = (f32x4){0.f, 0.f, 0.f, 0.f};
        const int nks = (wid >> 1) + 1;
        for (int ks = 0; ks < nks; ++ks) {
            const bf16x8 bfr = *(const LAS bf16x8*)(Wl + (16 * wid + r) * GW_STR + 32 * ks + 8 * q);
#pragma unroll
            for (int dt = 0; dt < 8; ++dt) { const bf16x8 afr = *(const LAS bf16x8*)(Vt + (16 * dt + r) * GW_STR + 32 * ks + 8 * q);
                acc[dt] = __builtin_amdgcn_mfma_f32_16x16x32_bf16(afr, bfr, acc[dt], 0, 0, 0); }
        }
        bf16_t* yp = Y + (R0 + gi_) * DM + h * 128 + 4 * q;
#pragma unroll
        for (int dt = 0; dt < 8; ++dt) { const u32x2 uu = ur[dt];
            u32x2 o; o.x = pk2(bflo(uu.x) * (acc[dt][0] + sb), bfhi(uu.x) * (acc[dt][1] + sb)); o.y = pk2(bflo(uu.y) * (acc[dt][2] + sb), bfhi(uu.y) * (acc[dt][3] + sb));
            *(u32x2*)(yp + 16 * dt) = o; }
        { const bf16_t* up = Z + (R1 + gi_) * INC + h * 128 + 4 * q;
#pragma unroll
          for (int dt = 0; dt < 8; ++dt) ur[dt] = *(const u32x2*)(up + 16 * dt); }
    }
}

constexpr int KL_STR = 72, VT_STR = 264;
__device__ __forceinline__ int t5_bucket(int n) { if (n < 16) return n; const float v = logf((float)n * (1.0f / 16.0f)) / 2.0794415416798357f * 16.0f; const int l = 16 + (int)v; return l < 31 ? l : 31; }
__device__ __forceinline__ void attn_phase(KA a, LAS unsigned char* lds, int bid, int nblk, int tid, int wid, int lane) {
    LAS bf16_t* Kl = (LAS bf16_t*)lds;
    LAS bf16_t* Vt = (LAS bf16_t*)(lds + 256 * KL_STR * 2);
    LAS float* tb = (LAS float*)(lds + 256 * KL_STR * 2 + 64 * VT_STR * 2);
    const bf16_t* Z = (const bf16_t*)(a->ws + WS_U); bf16_t* Y = (bf16_t*)(a->ws + WS_Y);
    const int r = lane & 15, q = lane >> 4;
    const float NEG = -__builtin_inff();
    constexpr float SC = 0.125f * LOG2E;
    for (int unit = bid; unit < 512; unit += nblk) {
        const int kvh = unit & 1, combo = unit >> 1, b = combo >> 6, nb = combo & 63; const size_t R0 = (size_t)b * SEQ + (size_t)nb * 128;
        __syncthreads();
        { const int key = tid >> 1, half = tid & 1; const bool valid = (nb > 0) || (key >= 128);
          u32x4 kr[4], vr[4];
          if (valid) { const bf16_t* kp = Z + (R0 - 128 + key) * INC + 3072 + kvh * 64 + half * 32; const bf16_t* vp = kp + 128;
#pragma unroll
              for (int k = 0; k < 4; ++k) { kr[k] = *(const u32x4*)(kp + 8 * k); vr[k] = *(const u32x4*)(vp + 8 * k); } }
          else {
#pragma unroll
              for (int k = 0; k < 4; ++k) { kr[k] = (u32x4){0u, 0u, 0u, 0u}; vr[k] = (u32x4){0u, 0u, 0u, 0u}; } }
          float kv[32]; float ss = 0.f;
#pragma unroll
          for (int k = 0; k < 4; ++k) { kv[8 * k + 0] = bflo(kr[k].x); kv[8 * k + 1] = bfhi(kr[k].x); kv[8 * k + 2] = bflo(kr[k].y); kv[8 * k + 3] = bfhi(kr[k].y);
              kv[8 * k + 4] = bflo(kr[k].z); kv[8 * k + 5] = bfhi(kr[k].z); kv[8 * k + 6] = bflo(kr[k].w); kv[8 * k + 7] = bfhi(kr[k].w); }
#pragma unroll
          for (int e = 0; e < 32; ++e) ss += kv[e] * kv[e];
          ss += __shfl_xor(ss, 1);
          const float rstd = 1.0f / sqrtf(ss * (1.0f / 64.0f) + EPS);
          const float* gk = a->in[I_GK] + half * 32;
#pragma unroll
          for (int k = 0; k < 4; ++k) { u32x4 o; o.x = pk2(kv[8 * k] * rstd * gk[8 * k], kv[8 * k + 1] * rstd * gk[8 * k + 1]); o.y = pk2(kv[8 * k + 2] * rstd * gk[8 * k + 2], kv[8 * k + 3] * rstd * gk[8 * k + 3]);
              o.z = pk2(kv[8 * k + 4] * rstd * gk[8 * k + 4], kv[8 * k + 5] * rstd * gk[8 * k + 5]); o.w = pk2(kv[8 * k + 6] * rstd * gk[8 * k + 6], kv[8 * k + 7] * rstd * gk[8 * k + 7]);
              *(LAS u32x4*)(Kl + key * KL_STR + half * 32 + 8 * k) = o; }
#pragma unroll
          for (int k = 0; k < 4; ++k) { const unsigned w4[4] = {vr[k].x, vr[k].y, vr[k].z, vr[k].w};
#pragma unroll
              for (int t = 0; t < 4; ++t) { Vt[(half * 32 + 8 * k + 2 * t) * VT_STR + key] = (bf16_t)(w4[t] & 0xffffu); Vt[(half * 32 + 8 * k + 2 * t + 1) * VT_STR + key] = (bf16_t)(w4[t] >> 16); } }
        }
        for (int idx = tid; idx < 1024; idx += NTHREADS) { const int g = idx >> 7, dist = idx & 127; tb[idx] = a->in[I_RELB][t5_bucket(dist) * 16 + kvh * 8 + g] * LOG2E; }
        __syncthreads();
        const int hq = kvh * 8 + wid;
        float breg[9][4];
#pragma unroll
        for (int t = 0; t < 9; ++t)
#pragma unroll
            for (int e = 0; e < 4; ++e) { const int dist = r + 128 - 16 * t - 4 * q - e; breg[t][e] = (dist >= 0 && dist < 128) ? tb[wid * 128 + (dist & 127)] : NEG; }
        const float sink2 = a->in[I_SINKS][hq] * LOG2E;
        float gq[2][8];
#pragma unroll
        for (int ks = 0; ks < 2; ++ks)
#pragma unroll
            for (int e = 0; e < 8; ++e) gq[ks][e] = a->in[I_GQ][32 * ks + 8 * q + e];
        u32x4 qn0, qn1;
        { const bf16_t* qp = Z + (R0 + r) * INC + 2 * AW + hq * 64 + 8 * q; qn0 = *(const u32x4*)qp; qn1 = *(const u32x4*)(qp + 32); }
        for (int c = 0; c < 8; ++c) {
            const u32x4 q0 = qn0, q1 = qn1;
            { const bf16_t* qp = Z + (R0 + 16 * (c < 7 ? c + 1 : c) + r) * INC + 2 * AW + hq * 64 + 8 * q; qn0 = *(const u32x4*)qp; qn1 = *(const u32x4*)(qp + 32); }
            float qv[2][8] = {{bflo(q0.x), bfhi(q0.x), bflo(q0.y), bfhi(q0.y), bflo(q0.z), bfhi(q0.z), bflo(q0.w), bfhi(q0.w)},
                              {bflo(q1.x), bfhi(q1.x), bflo(q1.y), bfhi(q1.y), bflo(q1.z), bfhi(q1.z), bflo(q1.w), bfhi(q1.w)}};
            float ss = 0.f;
#pragma unroll
            for (int ks = 0; ks < 2; ++ks)
#pragma unroll
                for (int e = 0; e < 8; ++e) ss += qv[ks][e] * qv[ks][e];
            ss += __shfl_xor(ss, 16); ss += __shfl_xor(ss, 32);
            const float rstd = 1.0f / sqrtf(ss * (1.0f / 64.0f) + EPS);
            bf16x8 qf[2];
#pragma unroll
            for (int ks = 0; ks < 2; ++ks) { u32x4 o; o.x = pk2(qv[ks][0] * rstd * gq[ks][0], qv[ks][1] * rstd * gq[ks][1]); o.y = pk2(qv[ks][2] * rstd * gq[ks][2], qv[ks][3] * rstd * gq[ks][3]);
                o.z = pk2(qv[ks][4] * rstd * gq[ks][4], qv[ks][5] * rstd * gq[ks][5]); o.w = pk2(qv[ks][6] * rstd * gq[ks][6], qv[ks][7] * rstd * gq[ks][7]); qf[ks] = __builtin_bit_cast(bf16x8, o); }
            f32x4 sacc[9];
#pragma unroll
            for (int t = 0; t < 9; ++t) { sacc[t] = (f32x4){0.f, 0.f, 0.f, 0.f};
#pragma unroll
                for (int ks = 0; ks < 2; ++ks) { const bf16x8 kf = *(const LAS bf16x8*)(Kl + (16 * (c + t) + r) * KL_STR + 32 * ks + 8 * q);
                    sacc[t] = __builtin_amdgcn_mfma_f32_16x16x32_bf16(kf, qf[ks], sacc[t], 0, 0, 0); } }
            float mx = sink2;
#pragma unroll
            for (int t = 0; t < 9; ++t) { const bool dead = (nb == 0) && (c + t < 8);
#pragma unroll
                for (int e = 0; e < 4; ++e) { float s = sacc[t][e] * SC + breg[t][e]; s = dead ? NEG : s; sacc[t][e] = s; mx = fmaxf(mx, s); } }
            mx = fmaxf(mx, __shfl_xor(mx, 16)); mx = fmaxf(mx, __shfl_xor(mx, 32));
            float l = 0.f;
#pragma unroll
            for (int t = 0; t < 9; ++t)
#pragma unroll
                for (int e = 0; e < 4; ++e) { const float p = __builtin_amdgcn_exp2f(sacc[t][e] - mx); sacc[t][e] = p; l += p; }
            l += __shfl_xor(l, 16); l += __shfl_xor(l, 32);
            l += __builtin_amdgcn_exp2f(sink2 - mx);
            const float inv = 1.0f / l;
            f32x4 o[4];
#pragma unroll
            for (int dt = 0; dt < 4; ++dt) o[dt] = (f32x4){0.f, 0.f, 0.f, 0.f};
#pragma unroll
            for (int kk = 0; kk < 5; ++kk) {
                u32x4 pw; pw.x = pk2(sacc[2 * kk][0], sacc[2 * kk][1]); pw.y = pk2(sacc[2 * kk][2], sacc[2 * kk][3]);
                if (kk < 4) { pw.z = pk2(sacc[(2 * kk + 1) % 9][0], sacc[(2 * kk + 1) % 9][1]); pw.w = pk2(sacc[(2 * kk + 1) % 9][2], sacc[(2 * kk + 1) % 9][3]); } else { pw.z = 0u; pw.w = 0u; }
                const bf16x8 pf = __builtin_bit_cast(bf16x8, pw);
#pragma unroll
                for (int dt = 0; dt < 4; ++dt) { const LAS bf16_t* vp = Vt + (16 * dt + r) * VT_STR + 16 * (c + 2 * kk) + 4 * q;
                    u32x4 av; const u32x2 lo = *(const LAS u32x2*)vp; av.x = lo.x; av.y = lo.y;
                    if (kk < 4) { const u32x2 hi = *(const LAS u32x2*)(vp + 16); av.z = hi.x; av.w = hi.y; } else { av.z = 0u; av.w = 0u; }
                    o[dt] = __builtin_amdgcn_mfma_f32_16x16x32_bf16(__builtin_bit_cast(bf16x8, av), pf, o[dt], 0, 0, 0); }
            }
            bf16_t* yp = Y + (R0 + 16 * c + r) * DM + AW + hq * 64 + 4 * q;
#pragma unroll
            for (int dt = 0; dt < 4; ++dt) { u32x2 w; w.x = pk2(o[dt][0] * inv, o[dt][1] * inv); w.y = pk2(o[dt][2] * inv, o[dt][3] * inv); *(u32x2*)(yp + 16 * dt) = w; }
        }
    }
}

static constexpr int SCHED_HOST[] = {MK_SCHED};
constexpr int NPH = (int)(sizeof(SCHED_HOST) / sizeof(int));
__global__ void __launch_bounds__(NTHREADS, 2) fwd_megakernel(Args args) {
    extern __shared__ __attribute__((aligned(16))) unsigned char lds_raw[];
    LAS unsigned char* lds = (LAS unsigned char*)lds_raw;
    KA ka0 = (KA)__builtin_amdgcn_kernarg_segment_ptr();
    const int ph_lo = ka0->ph_lo, ph_hi = ka0->ph_hi;
    const int wid0 = __builtin_amdgcn_readfirstlane(threadIdx.x >> 6);
    volatile LAS unsigned* misc = (volatile LAS unsigned*)(lds + 131072);
    if (threadIdx.x < 64) misc[threadIdx.x] = 0u;
    if (blockIdx.x == 0 && ph_lo == 0) { unsigned* bw = (unsigned*)(ka0->ws + WS_BAR); for (int i = threadIdx.x; i < XCD_BAR_WORDS; i += NTHREADS) bw[i] = 0u; }
    __syncthreads();
    XcdBarrier xbar; xbar.bar = (unsigned*)(ka0->ws + WS_BAR); xbar.x = 0; xbar.st = misc;
    bool xbar_posted = false;
    static constexpr int SCHED[] = {MK_SCHED};
    constexpr int NS = (int)(sizeof(SCHED) / sizeof(int));
    for (int si = ph_lo; si < ph_hi; ++si) {
        const int ph = SCHED[si];
        KA ka = ka0; asm volatile("" : "+s"(ka));
        int wid_s = wid0; asm volatile("" : "+s"(wid_s));
        int tid = wid_s * 64 + (int)__builtin_amdgcn_mbcnt_hi(~0u, __builtin_amdgcn_mbcnt_lo(~0u, 0u)); asm volatile("" : "+v"(tid));
        int bid = blockIdx.x, G = gridDim.x; asm volatile("" : "+s"(bid), "+s"(G));
        const int lane = tid & 63, wid = __builtin_amdgcn_readfirstlane(tid >> 6);
        const int gw = bid * NWAVES + wid, ngw = G * NWAVES;
        unsigned char* ws = ka->ws;
        float* mod = (float*)(ws + WS_MOD);
        bf16_t* H = (bf16_t*)(ws + WS_H); bf16_t* Y = (bf16_t*)(ws + WS_Y); bf16_t* U = (bf16_t*)(ws + WS_U);
        switch (ph) {
        case 0: {
            LAS float* scr = (LAS float*)(lds + wid * 16384);
            for (int it = gw; it < N_CONV_ITEMS + N_MOD_ITEMS; it += ngw) {
                if (it < N_MOD_ITEMS) mod_item(ka, it, scr, lane); else conv_dispatch(ka, it - N_MOD_ITEMS, scr, lane);
            }
        } break;
        case 1: {
            const float* part = (const float*)(ws + WS_PART); const float* bada = ka->in[I_BADA];
            for (int o = bid * NTHREADS + tid; o < BATCH * MODW; o += G * NTHREADS) { const int b = o / MODW, n = o % MODW; float s = bada[n];
#pragma unroll 8
                for (int kc = 0; kc < NKC; ++kc) s += part[(size_t)(kc * 4 + b) * MODW + n];
                mod[o] = s; }
        } break;
        case 2: {
            float* ssq = (float*)(ws + WS_SSQ); float* b2 = (float*)(ws + WS_B2);
            prologue_pass(ka->in[I_X], ka->in[I_GF1], mod, 1, H, ssq, gw, ngw, lane);
            bias_gemv((const bf16_t*)(ws + WS_W13A), 2 * DFF, mod + 0 * DM, b2, gw, ngw, lane);
            bias_gemv((const bf16_t*)(ws + WS_WIN), INC, mod + 3 * DM, b2 + 4 * 2 * DFF, gw, ngw, lane);
            bias_gemv((const bf16_t*)(ws + WS_W13B), 2 * DFF, mod + 6 * DM, b2 + 4 * 2 * DFF + 4 * INC, gw, ngw, lane);
            for (int i = bid * NTHREADS + tid; i < 2 * M; i += G * NTHREADS) ssq[M + i] = 0.f;
        } break;
        case 3: case 10: {
            const bool first = (ph == 3);
            pg8::Gemm g{H, (const bf16_t*)(ws + (first ? WS_W13A : WS_W13B)), M, 2 * DFF, DM}; pg8::StaticOrder S; S.init(M, 2 * DFF, G, bid);
            pg8::EpiSwiGLU E{U, DFF, (const float*)(ws + WS_SSQ) + (first ? 0 : 2 * M), (const float*)(ws + WS_B2) + (first ? 0 : 4 * 2 * DFF + 4 * INC), 2 * DFF, SEQ / 256};
            pg8::gemm_phase<pg8::EpiSwiGLU, pg8::StaticOrder, true, true>(lds, g, S, E, tid);
        } break;
        case 4: {
            pg8::Gemm g{U, (const bf16_t*)(ws + WS_W2A), M, DM, DFF}; pg8::StaticOrder S; S.init(M, DM, G, bid);
            EpiResidK<0> E{ka0};
            pg8::gemm_phase<EpiResidK<0>, pg8::StaticOrder, false, true>(lds, g, S, E, tid);
        } break;
        case 8: {
            pg8::Gemm g{Y, (const bf16_t*)(ws + WS_WOUT), M, DM, DM}; pg8::StaticOrder S; S.init(M, DM, G, bid);
            EpiResidK<1> E{ka0};
            pg8::gemm_phase<EpiResidK<1>, pg8::StaticOrder, false, true>(lds, g, S, E, tid);
        } break;
        case 11: {
            pg8::Gemm g{U, (const bf16_t*)(ws + WS_W2B), M, DM, DFF}; pg8::StaticOrder S; S.init(M, DM, G, bid);
            EpiResidK<2> E{ka0};
            pg8::gemm_phase<EpiResidK<2>, pg8::StaticOrder, false, true>(lds, g, S, E, tid);
        } break;
        case 6: {
            pg8::Gemm g{H, (const bf16_t*)(ws + WS_WIN), M, INC, DM}; pg8::StaticOrder S; S.init(M, INC, G, bid);
            pg8::EpiZ E{U, INC, 8, (const float*)(ws + WS_SSQ) + M, (const float*)(ws + WS_B2) + 4 * 2 * DFF, INC, SEQ / 256};
            pg8::gemm_phase<pg8::EpiZ, pg8::StaticOrder, true, true>(lds, g, S, E, tid);
        } break;
        case 7: {
            gmlp_phase(ka, lds, bid, tid, wid, lane);
            attn_phase(ka, lds, bid, G, tid, wid, lane);
        } break;
        default: break;
        }
        if (si + 1 < ph_hi) {
            for (int rep = 0; rep < MK_SYNC_REPEAT; ++rep) {
                if (!xbar_posted) { cg::this_grid().sync(); xbar = xcd_barrier_post((unsigned*)(ka0->ws + WS_BAR), misc); xbar_posted = true; }
                else xcd_barrier(xbar);
            }
        }
    }
}

extern "C" void kernel_launch(void* const* d_in, const int* in_sizes, int n_in, void* d_out, int out_size, void* d_ws, size_t ws_size, hipStream_t stream) {
    static int grid = 0;
    if (grid == 0) {
        if (n_in != 22 || out_size != M * DM || ws_size < WS_END) { fprintf(stderr, "kernel_launch: unexpected shapes (n_in %d out %d ws %zu)\n", n_in, out_size, ws_size); grid = -1; return; }
        int dev = 0, cus = 0, per_cu = 0;
        (void)hipGetDevice(&dev); (void)hipDeviceGetAttribute(&cus, hipDeviceAttributeMultiprocessorCount, dev);
        if (hipFuncSetAttribute((const void*)fwd_megakernel, hipFuncAttributeMaxDynamicSharedMemorySize, LDS_BYTES) != hipSuccess) { fprintf(stderr, "kernel_launch: hipFuncSetAttribute failed\n"); grid = -1; return; }
        if (hipOccupancyMaxActiveBlocksPerMultiprocessor(&per_cu, (const void*)fwd_megakernel, NTHREADS, LDS_BYTES) != hipSuccess || per_cu < 1) { fprintf(stderr, "kernel_launch: occupancy query says %d\n", per_cu); per_cu = 1; }
        (void)hipGetLastError();
        grid = cus;
        if (grid != 256) fprintf(stderr, "kernel_launch: %d CUs (built for 256)\n", grid);
    }
    if (grid < 0) return;
    Args a{};
    for (int i = 0; i < 22; ++i) a.in[i] = (const float*)d_in[i];
    a.out = (float*)d_out; a.ws = (unsigned char*)d_ws;
#if MK_PER_PHASE
    for (int p = 0; p < NPH; ++p) { a.ph_lo = p; a.ph_hi = p + 1; hipLaunchKernelGGL(fwd_megakernel, dim3(grid), dim3(NTHREADS), LDS_BYTES, stream, a); }
#else
    a.ph_lo = 0; a.ph_hi = NPH;
    void* kargs[] = {(void*)&a};
    hipError_t e = hipLaunchCooperativeKernel((const void*)fwd_megakernel, dim3(grid), dim3(NTHREADS), kargs, LDS_BYTES, stream);
    if (e != hipSuccess) fprintf(stderr, "kernel_launch: cooperative launch failed: %s (grid %d)\n", hipGetErrorString(e), grid);
#endif
}
```

```cpp
#include <hip/hip_runtime.h>
#include <hip/hip_cooperative_groups.h>
#include <cstdio>
#include <cstdint>
namespace cg = cooperative_groups;

#ifndef MK_SCHED
#define MK_SCHED 0, 1, 2, 3, 4, 6, 7, 8, 10, 11
#endif
#ifndef MK_EPI_REP_UP
#define MK_EPI_REP_UP 1
#endif
#ifndef MK_EPI_REP_OUT
#define MK_EPI_REP_OUT 1
#endif
#ifndef MK_SYNC_REPEAT
#define MK_SYNC_REPEAT 1
#endif
#ifndef MK_PER_PHASE
#define MK_PER_PHASE 0
#endif

namespace pg8 {
#define PG8_LAS __attribute__((address_space(3)))
typedef unsigned short bf16_t;
typedef short bf16x8 __attribute__((ext_vector_type(8)));
typedef float f32x4 __attribute__((ext_vector_type(4)));
typedef float f32x2 __attribute__((ext_vector_type(2)));
typedef unsigned u32x4 __attribute__((ext_vector_type(4)));
typedef unsigned u32x2 __attribute__((ext_vector_type(2)));
constexpr int BM = 256, BK = 64, HALF = 128, HTB = HALF * BK * 2, STAGE_BYTES = 8 * HTB, NXCD = 8, WGM = 4;
constexpr int EPI_LDS_OFF = STAGE_BYTES + 1024;

__host__ __device__ __forceinline__ int lds_byte(int r, int c) { const int st = (r >> 4) * 2 + (c >> 5), rr = r & 15, cc = c & 31, ob = rr * 64 + cc * 2; return st * 1024 + (ob ^ (((ob >> 9) & 1) << 5)); }
__host__ __device__ __forceinline__ void stage_rc(int b, int& R, int& C) { const int st = b / 1024, sb = b % 1024, swz = sb ^ (((sb >> 9) & 1) << 5); R = (st >> 1) * 16 + swz / 64; C = (st & 1) * 32 + (swz % 64) / 2; }
__host__ __device__ __forceinline__ int perm32(int rho) { const int n = rho >> 4, i = rho & 15; return 8 * (i >> 2) + 4 * n + (i & 3); }

struct Unit { int pm, pn; };
struct Gemm { const bf16_t* A; const bf16_t* Bt; int M, N, K; };

struct StaticOrder {
    int nM, nN, nwg, G, c;
    __host__ __device__ void init(int M, int N, int G_, int c_) { nM = M / BM; nN = N / BM; nwg = nM * nN; G = G_; c = c_; }
    __host__ __device__ bool next(int i, Unit& u) const {
        const long L = (long)i * G + c; if (L >= nwg) return false;
        int wgid = (int)L; { const int q = nwg / NXCD, r = nwg % NXCD, xcd = wgid % NXCD, off = wgid / NXCD; wgid = (xcd < r ? xcd * (q + 1) : r * (q + 1) + (xcd - r) * q) + off; }
        const int nig = WGM * nN, gid = wgid / nig, fm = gid * WGM, gsz = (nM - fm) < WGM ? (nM - fm) : WGM;
        u.pm = fm + ((wgid % nig) % gsz); u.pn = (wgid % nig) / gsz; return true;
    }
    __device__ __forceinline__ void a_ready(const Unit&) const {}
    __device__ __forceinline__ void done(const Unit&) const {}
};

__device__ __forceinline__ unsigned cvt_pk_bf16(float lo, float hi) { unsigned r; asm volatile("v_cvt_pk_bf16_f32 %0, %1, %2" : "=v"(r) : "v"(lo), "v"(hi)); return r; }
__device__ __forceinline__ f32x2 gelu_pk(f32x2 v) {
    const f32x2 av = __builtin_elementwise_abs(v), d = av * 0.2316418882f + 1.0f;
    f32x2 t; t.x = __builtin_amdgcn_rcpf(d.x); t.y = __builtin_amdgcn_rcpf(d.y);
    f32x2 q = t * 0.5307027145f + (-0.7265760135f); q = q * t + 0.7107068705f; q = q * t + (-0.142248368f); q = q * t + 0.127414796f; q = q * t;
    const f32x2 s = (v * v) * (-0.72134752044f);
    f32x2 e; e.x = __builtin_amdgcn_exp2f(s.x); e.y = __builtin_amdgcn_exp2f(s.y);
    const f32x2 m = v * (q * e), r = v - m;
    f32x2 o; o.x = v.x < 0.f ? m.x : r.x; o.y = v.y < 0.f ? m.y : r.y; return o;
}
__device__ __forceinline__ f32x2 silu_mul_pk(f32x2 a, f32x2 b) {
    const f32x2 t = a * (-1.4426950408889634f); f32x2 e; e.x = __builtin_amdgcn_exp2f(t.x); e.y = __builtin_amdgcn_exp2f(t.y);
    const f32x2 d = e + 1.0f; f32x2 r; r.x = __builtin_amdgcn_rcpf(d.x); r.y = __builtin_amdgcn_rcpf(d.y);
    return (a * b) * r;
}
__device__ __forceinline__ float silu_f(float a) { return a * __builtin_amdgcn_rcpf(1.0f + __builtin_amdgcn_exp2f(a * -1.4426950408889634f)); }


struct EpiSwiGLU {
    static constexpr bool PERM = true, AFTER_DRAIN = false; static constexpr int REP = MK_EPI_REP_UP;
    bf16_t* O; int ldc; const float* ssq; const float* bias2; int bias_stride; int tiles_per_batch;
    __device__ __forceinline__ void prefetch(PG8_LAS unsigned char* sl, const Unit& u, int wr, int wc, int lane) const {
        const float* sp = ssq + u.pm * BM + wr * 64 + lane;
        __builtin_amdgcn_global_load_lds((const unsigned*)sp, (PG8_LAS unsigned*)sl, 4, 0, 0);
        __builtin_amdgcn_global_load_lds((const unsigned*)(sp + HALF), (PG8_LAS unsigned*)(sl + 256), 4, 0, 0);
        const float* bp = bias2 + (size_t)(u.pm / tiles_per_batch) * bias_stride + u.pn * BM + wc * 32 + (lane & 31) + (lane >> 5) * HALF;
        __builtin_amdgcn_global_load_lds((const unsigned*)bp, (PG8_LAS unsigned*)(sl + 512), 4, 0, 0);
    }
    __device__ __forceinline__ void operator()(const f32x4 (&acc)[2][2][4][2], const Unit& u, int wr, int wc, int fr, int fq, PG8_LAS unsigned char* sl) const {
        const int row0 = u.pm * BM + wr * 64 + fr, col0 = u.pn * HALF + wc * 32 + 8 * fq;
        const PG8_LAS float* sf = (const PG8_LAS float*)sl;
        f32x4 bw[2][2];
#pragma unroll
        for (int bj = 0; bj < 2; ++bj)
#pragma unroll
            for (int n = 0; n < 2; ++n) bw[bj][n] = *(const PG8_LAS f32x4*)(sf + 128 + bj * 32 + 8 * fq + 4 * n);
#pragma unroll
        for (int ai = 0; ai < 2; ++ai)
#pragma unroll
            for (int m = 0; m < 4; ++m) { const int row = row0 + ai * HALF + m * 16; bf16_t* rowp = O + (size_t)row * ldc + col0;
                const float rs = __builtin_amdgcn_rsqf(sf[ai * 64 + m * 16 + fr] * (1.0f / 2048.0f) + 1e-6f);
                const f32x4 a0 = acc[ai][0][m][0] * rs + bw[0][0], a1 = acc[ai][0][m][1] * rs + bw[0][1], b0 = acc[ai][1][m][0] * rs + bw[1][0], b1 = acc[ai][1][m][1] * rs + bw[1][1];
                const f32x2 s0 = silu_mul_pk((f32x2){a0[0], a0[1]}, (f32x2){b0[0], b0[1]}), s1 = silu_mul_pk((f32x2){a0[2], a0[3]}, (f32x2){b0[2], b0[3]});
                const f32x2 s2 = silu_mul_pk((f32x2){a1[0], a1[1]}, (f32x2){b1[0], b1[1]}), s3 = silu_mul_pk((f32x2){a1[2], a1[3]}, (f32x2){b1[2], b1[3]});
                u32x4 w; w.x = cvt_pk_bf16(s0.x, s0.y); w.y = cvt_pk_bf16(s1.x, s1.y); w.z = cvt_pk_bf16(s2.x, s2.y); w.w = cvt_pk_bf16(s3.x, s3.y);
                *(u32x4*)rowp = w; }
    }
};
struct EpiZ {
    static constexpr bool PERM = true, AFTER_DRAIN = false; static constexpr int REP = 1;
    bf16_t* O; int ldc; int gelu_tiles; const float* ssq; const float* bias2; int bias_stride; int tiles_per_batch;
    __device__ __forceinline__ void prefetch(PG8_LAS unsigned char* sl, const Unit& u, int wr, int wc, int lane) const {
        const float* sp = ssq + u.pm * BM + wr * 64 + lane;
        __builtin_amdgcn_global_load_lds((const unsigned*)sp, (PG8_LAS unsigned*)sl, 4, 0, 0);
        __builtin_amdgcn_global_load_lds((const unsigned*)(sp + HALF), (PG8_LAS unsigned*)(sl + 256), 4, 0, 0);
        const float* bp = bias2 + (size_t)(u.pm / tiles_per_batch) * bias_stride + u.pn * BM + wc * 32 + (lane & 31) + (lane >> 5) * HALF;
        __builtin_amdgcn_global_load_lds((const unsigned*)bp, (PG8_LAS unsigned*)(sl + 512), 4, 0, 0);
    }
    __device__ __forceinline__ void operator()(const f32x4 (&acc)[2][2][4][2], const Unit& u, int wr, int wc, int fr, int fq, PG8_LAS unsigned char* sl) const {
        const int row0 = u.pm * BM + wr * 64 + fr, col0 = u.pn * BM + wc * 32 + 8 * fq;
        const bool act = u.pn < gelu_tiles;
        const PG8_LAS float* sf = (const PG8_LAS float*)sl;
        f32x4 bw[2][2];
#pragma unroll
        for (int bj = 0; bj < 2; ++bj)
#pragma unroll
            for (int n = 0; n < 2; ++n) bw[bj][n] = *(const PG8_LAS f32x4*)(sf + 128 + bj * 32 + 8 * fq + 4 * n);
#pragma unroll
        for (int ai = 0; ai < 2; ++ai)
#pragma unroll
            for (int m = 0; m < 4; ++m) { const int row = row0 + ai * HALF + m * 16; bf16_t* rowp = O + (size_t)row * ldc + col0;
                const float rs = __builtin_amdgcn_rsqf(sf[ai * 64 + m * 16 + fr] * (1.0f / 2048.0f) + 1e-6f);
#pragma unroll
                for (int bj = 0; bj < 2; ++bj) { f32x4 v0 = acc[ai][bj][m][0] * rs + bw[bj][0], v1 = acc[ai][bj][m][1] * rs + bw[bj][1];
                    if (act) { f32x2 a = gelu_pk((f32x2){v0[0], v0[1]}), b = gelu_pk((f32x2){v0[2], v0[3]}), c = gelu_pk((f32x2){v1[0], v1[1]}), d = gelu_pk((f32x2){v1[2], v1[3]});
                        v0 = (f32x4){a.x, a.y, b.x, b.y}; v1 = (f32x4){c.x, c.y, d.x, d.y}; }
                    u32x4 w; w.x = cvt_pk_bf16(v0[0], v0[1]); w.y = cvt_pk_bf16(v0[2], v0[3]); w.z = cvt_pk_bf16(v1[0], v1[1]); w.w = cvt_pk_bf16(v1[2], v1[3]);
                    *(u32x4*)(rowp + bj * HALF) = w; } }
    }
};

template <class Epi, class Sched, bool ALIGN_EPI = false, bool SP2 = false>
__device__ __forceinline__ void gemm_phase(PG8_LAS unsigned char* lds, const Gemm g, const Sched& S, const Epi& E, const int tid) {
    const int wid = __builtin_amdgcn_readfirstlane(tid >> 6), lane = tid & 63, wr = wid >> 2, wc = wid & 3, fr = lane & 15, fq = lane >> 4;
    const int K = g.K, nt = K / BK;
    unsigned voffA[2], voffB[2];
#pragma unroll
    for (int i = 0; i < 2; ++i) { int R, C; stage_rc(tid * 16 + i * 8192, R, C); const int Rb = Epi::PERM ? ((R & ~31) + perm32(R & 31)) : R;
        voffA[i] = (unsigned)(R * K + C) * 2u; voffB[i] = (unsigned)(Rb * K + C) * 2u; }
    const size_t kstep = (size_t)(BK * 2);
    const size_t hstep = (size_t)HALF * K * 2;
    const size_t tstep = 2 * hstep;
    const unsigned ldsw = (unsigned)wid * 1024u;
    const int aoff = lds_byte(wr * 64 + fr, fq * 8), boff = lds_byte(wc * 32 + fr, fq * 8);
#define PG8_SA(b, h) (((b) * 2 + (h)) * HTB)
#define PG8_SB(b, h) ((4 + (b) * 2 + (h)) * HTB)
#define PG8_STAGE(bufoff, gbase, voff) do { _Pragma("unroll") for (int _i = 0; _i < 2; ++_i) \
        __builtin_amdgcn_global_load_lds((const unsigned*)((const char*)(gbase) + (voff)[_i]), (PG8_LAS unsigned*)(lds + (bufoff) + ldsw + _i * 8192), 16, 0, 0); } while (0)
#define PG8_LDA(dst, b, h) do { _Pragma("unroll") for (int m = 0; m < 4; ++m) _Pragma("unroll") for (int k = 0; k < 2; ++k) dst[m][k] = *(const PG8_LAS bf16x8*)(lds + PG8_SA(b, h) + aoff + m * 2048 + k * 1024); } while (0)
#define PG8_LDB(dst, b, h) do { _Pragma("unroll") for (int n = 0; n < 2; ++n) _Pragma("unroll") for (int k = 0; k < 2; ++k) dst[n][k] = *(const PG8_LAS bf16x8*)(lds + PG8_SB(b, h) + boff + n * 2048 + k * 1024); } while (0)
#define PG8_MMA(ai, bj, At, Bt) do { __builtin_amdgcn_s_setprio(1); _Pragma("unroll") for (int m = 0; m < 4; ++m) _Pragma("unroll") for (int n = 0; n < 2; ++n) _Pragma("unroll") for (int k = 0; k < 2; ++k) \
        acc[ai][bj][m][n] = __builtin_amdgcn_mfma_f32_16x16x32_bf16(Bt[n][k], At[m][k], acc[ai][bj][m][n], 0, 0, 0); __builtin_amdgcn_s_setprio(0); } while (0)
#define PG8_WAIT_V(n) asm volatile("s_waitcnt vmcnt(" #n ")" ::: "memory")
#define PG8_WAIT_L(n) asm volatile("s_waitcnt lgkmcnt(" #n ")" ::: "memory")
#define PG8_BAR __builtin_amdgcn_s_barrier()
#define PG8_SCHED __builtin_amdgcn_sched_barrier(0)
    Unit cur, nxt; int ui = 0;
    if (!S.next(0, cur)) return;
    f32x4 acc[2][2][4][2];
#pragma unroll
    for (int a = 0; a < 2; ++a)
#pragma unroll
        for (int b = 0; b < 2; ++b)
#pragma unroll
            for (int m = 0; m < 4; ++m)
#pragma unroll
                for (int n = 0; n < 2; ++n) acc[a][b][m][n] = (f32x4){0.f, 0.f, 0.f, 0.f};
    bf16x8 At[4][2], B0[2][2], B1[2][2];
    const char* cA = (const char*)g.A + (size_t)cur.pm * tstep; const char* cB = (const char*)g.Bt + (size_t)cur.pn * tstep;
    S.a_ready(cur);
    if constexpr (SP2) {
        PG8_STAGE(PG8_SB(0, 0), cB, voffB); PG8_STAGE(PG8_SB(0, 1), cB + hstep, voffB); PG8_STAGE(PG8_SA(0, 0), cA, voffA); PG8_STAGE(PG8_SA(0, 1), cA + hstep, voffA);
        if (wr == 1) PG8_BAR;
        PG8_WAIT_V(2); PG8_BAR;
        PG8_STAGE(PG8_SB(1, 0), cB + kstep, voffB); PG8_STAGE(PG8_SA(1, 0), cA + kstep, voffA); PG8_STAGE(PG8_SB(1, 1), cB + hstep + kstep, voffB);
        PG8_WAIT_V(6); PG8_BAR;
    } else {
        PG8_STAGE(PG8_SB(0, 0), cB, voffB); PG8_STAGE(PG8_SA(0, 0), cA, voffA); PG8_STAGE(PG8_SB(0, 1), cB + hstep, voffB); PG8_STAGE(PG8_SA(0, 1), cA + hstep, voffA);
        if (wr == 1) PG8_BAR;
        PG8_WAIT_V(4); PG8_BAR;
        PG8_STAGE(PG8_SB(1, 0), cB + kstep, voffB); PG8_STAGE(PG8_SA(1, 0), cA + kstep, voffA); PG8_STAGE(PG8_SB(1, 1), cB + hstep + kstep, voffB);
        PG8_WAIT_V(6); PG8_BAR;
    }
    for (;;) {
        const bool has_next = S.next(ui + 1, nxt);
        const char* nA = has_next ? (const char*)g.A + (size_t)nxt.pm * tstep : cA; const char* nB = has_next ? (const char*)g.Bt + (size_t)nxt.pn * tstep : cB;
        for (int t = 0; t < nt; t += 2) {
            const bool last = (t == nt - 2);
            const char* a1 = cA + (size_t)(t + 1) * kstep;
            const char* a2 = last ? nA : cA + (size_t)(t + 2) * kstep; const char* b2 = last ? nB : cB + (size_t)(t + 2) * kstep;
            const char* a3 = a2 + kstep; const char* b3 = b2 + kstep;
            if (last && has_next) S.a_ready(nxt);
            if (last) E.prefetch(lds + EPI_LDS_OFF + wid * 1024, cur, wr, wc, lane);
            if constexpr (SP2) {
            PG8_LDB(B0, 0, 0); PG8_LDB(B1, 0, 1); PG8_SCHED; PG8_LDA(At, 0, 0); PG8_STAGE(PG8_SA(1, 1), a1 + hstep, voffA);
            PG8_WAIT_V(8); PG8_WAIT_L(0); PG8_BAR; PG8_MMA(0, 0, At, B0); PG8_MMA(0, 1, At, B1); PG8_BAR; PG8_SCHED;
            PG8_LDA(At, 0, 1); PG8_STAGE(PG8_SB(0, 0), b2, voffB); PG8_STAGE(PG8_SB(0, 1), b2 + hstep, voffB); PG8_STAGE(PG8_SA(0, 0), a2, voffA);
            PG8_WAIT_V(8); PG8_WAIT_L(0); PG8_BAR; PG8_MMA(1, 0, At, B0); PG8_MMA(1, 1, At, B1); PG8_BAR; PG8_SCHED;
            PG8_LDB(B0, 1, 0); PG8_LDB(B1, 1, 1); PG8_SCHED; PG8_LDA(At, 1, 0); PG8_STAGE(PG8_SA(0, 1), a2 + hstep, voffA);
            PG8_WAIT_V(8); PG8_WAIT_L(0); PG8_BAR; PG8_MMA(0, 0, At, B0); PG8_MMA(0, 1, At, B1); PG8_BAR; PG8_SCHED;
            PG8_LDA(At, 1, 1); PG8_STAGE(PG8_SB(1, 0), b3, voffB); PG8_STAGE(PG8_SB(1, 1), b3 + hstep, voffB); PG8_STAGE(PG8_SA(1, 0), a3, voffA);
            PG8_WAIT_V(8); PG8_WAIT_L(0); PG8_BAR; PG8_MMA(1, 0, At, B0); PG8_MMA(1, 1, At, B1); PG8_BAR; PG8_SCHED;
            } else {
            PG8_LDB(B0, 0, 0); PG8_SCHED; PG8_LDA(At, 0, 0); PG8_STAGE(PG8_SA(1, 1), a1 + hstep, voffA);
            PG8_WAIT_L(8); PG8_BAR; PG8_WAIT_L(0); PG8_MMA(0, 0, At, B0); PG8_BAR; PG8_SCHED;
            PG8_LDB(B1, 0, 1); PG8_STAGE(PG8_SB(0, 0), b2, voffB);
            PG8_BAR; PG8_WAIT_L(0); PG8_MMA(0, 1, At, B1); PG8_BAR;
            PG8_LDA(At, 0, 1); PG8_STAGE(PG8_SA(0, 0), a2, voffA);
            PG8_BAR; PG8_WAIT_L(0); PG8_MMA(1, 0, At, B0); PG8_BAR; PG8_SCHED;
            PG8_STAGE(PG8_SB(0, 1), b2 + hstep, voffB);
            PG8_WAIT_V(6); PG8_BAR; PG8_MMA(1, 1, At, B1); PG8_BAR;
            PG8_LDB(B0, 1, 0); PG8_SCHED; PG8_LDA(At, 1, 0); PG8_STAGE(PG8_SA(0, 1), a2 + hstep, voffA);
            PG8_WAIT_L(8); PG8_BAR; PG8_WAIT_L(0); PG8_MMA(0, 0, At, B0); PG8_BAR; PG8_SCHED;
            PG8_LDB(B1, 1, 1); PG8_STAGE(PG8_SB(1, 0), b3, voffB);
            PG8_BAR; PG8_WAIT_L(0); PG8_MMA(0, 1, At, B1); PG8_BAR;
            PG8_LDA(At, 1, 1); PG8_STAGE(PG8_SA(1, 0), a3, voffA);
            PG8_BAR; PG8_WAIT_L(0); PG8_MMA(1, 0, At, B0); PG8_BAR; PG8_SCHED;
            PG8_STAGE(PG8_SB(1, 1), b3 + hstep, voffB);
            PG8_WAIT_V(6); PG8_BAR; PG8_MMA(1, 1, At, B1); PG8_BAR;
            }
        }
        if constexpr (ALIGN_EPI) { if (wr == 0) PG8_BAR; }
        for (int er = 0; er < Epi::REP; ++er) { E(acc, cur, wr, wc, fr, fq, lds + EPI_LDS_OFF + wid * 1024); if (Epi::REP > 1) asm volatile("" ::: "memory"); }
        S.done(cur);
        if (!has_next) break;
#pragma unroll
        for (int a = 0; a < 2; ++a)
#pragma unroll
            for (int b = 0; b < 2; ++b)
#pragma unroll
                for (int m = 0; m < 4; ++m)
#pragma unroll
                    for (int n = 0; n < 2; ++n) acc[a][b][m][n] = (f32x4){0.f, 0.f, 0.f, 0.f};
        cur = nxt; cA = nA; cB = nB; ++ui;
        if constexpr (ALIGN_EPI) { if (wr == 1) PG8_BAR; }
    }
    PG8_WAIT_V(0);
    if constexpr (!ALIGN_EPI) { if (wr == 0) PG8_BAR; }
    PG8_BAR;
#undef PG8_SA
#undef PG8_SB
#undef PG8_STAGE
#undef PG8_LDA
#undef PG8_LDB
#undef PG8_MMA
#undef PG8_WAIT_V
#undef PG8_WAIT_L
#undef PG8_BAR
#undef PG8_SCHED
}
}

constexpr int DM = 2048, BATCH = 4, SEQ = 8192, M = BATCH * SEQ;
constexpr int AW = 1024, BW = 1024, KVW = 128, INC = 3328, DFF = 5632, NMOD = 9;
constexpr int MODW = NMOD * DM;
constexpr float EPS = 1e-6f, LOG2E = 1.4426950408889634f;
constexpr int NWAVES = 8, NTHREADS = 512;
constexpr int LDS_BYTES = 131072 + 1024 + 8192;
constexpr int NKC = 64, KCH = DM / NKC;

constexpr size_t MiB = 1u << 20;
constexpr size_t WS_MOD = 0;
constexpr size_t WS_BAR = 512 * 1024;
constexpr size_t WS_PART = 1 * MiB;
constexpr size_t WS_SSQ = 20 * MiB;
constexpr size_t WS_B2 = 21 * MiB;
constexpr size_t WS_W13A = 24 * MiB;
constexpr size_t WS_W2A = 68 * MiB;
constexpr size_t WS_WIN = 90 * MiB;
constexpr size_t WS_WOUT = 103 * MiB;
constexpr size_t WS_W13B = 111 * MiB;
constexpr size_t WS_W2B = 155 * MiB;
constexpr size_t WS_H = 177 * MiB;
constexpr size_t WS_Y = 305 * MiB;
constexpr size_t WS_U = 433 * MiB;
constexpr size_t WS_XH = 785 * MiB;
constexpr size_t WS_END = 913 * MiB;

typedef unsigned short bf16_t;
typedef short bf16x8 __attribute__((ext_vector_type(8)));
typedef short bf16x4 __attribute__((ext_vector_type(4)));
typedef float f32x4 __attribute__((ext_vector_type(4)));
typedef unsigned u32x4 __attribute__((ext_vector_type(4)));
typedef unsigned u32x2 __attribute__((ext_vector_type(2)));
#define LAS __attribute__((address_space(3)))
#define LDS_WAIT() asm volatile("s_waitcnt lgkmcnt(0)" ::: "memory")

__device__ __forceinline__ unsigned f2bf(float f) { unsigned u = __builtin_bit_cast(unsigned, f); return (u + 0x7fffu + ((u >> 16) & 1u)) >> 16; }
__device__ __forceinline__ unsigned pk2(float lo, float hi) { return pg8::cvt_pk_bf16(lo, hi); }
__device__ __forceinline__ float bf2f(unsigned short b) { return __builtin_bit_cast(float, (unsigned)b << 16); }
__device__ __forceinline__ float bflo(unsigned w) { return __builtin_bit_cast(float, w << 16); }
__device__ __forceinline__ float bfhi(unsigned w) { return __builtin_bit_cast(float, w & 0xffff0000u); }
__device__ __forceinline__ float wave_sum(float v) {
#pragma unroll
    for (int o = 1; o < 64; o <<= 1) v += __shfl_xor(v, o);
    return v;
}


#define XB_TMO      128
#define XB_XCNT(j)  (256  + 64 * (j))
#define XB_XSUB(j)  (1280 + 64 * (j))
#define XB_XGEN(j)  (2304 + 64 * (j))
#define XB_TOP      3328
#define XB_TOPGEN   3392
#define XCD_BAR_WORDS 3456
#define XB_SPIN_CAP (1u << 22)
__device__ __forceinline__ unsigned xb_ld(unsigned* p)              { return __hip_atomic_load(p, __ATOMIC_RELAXED, __HIP_MEMORY_SCOPE_AGENT); }
__device__ __forceinline__ unsigned xb_add(unsigned* p, unsigned v) { return __hip_atomic_fetch_add(p, v, __ATOMIC_RELAXED, __HIP_MEMORY_SCOPE_AGENT); }
__device__ __forceinline__ unsigned xb_xcc_id() { return (unsigned)__builtin_amdgcn_s_getreg((3 << 11) | 20) & 0xFu; }
#define XB_SPIN(cond, bar) do { unsigned _sp = 0; while (cond) { __builtin_amdgcn_s_sleep(1); \
    if ((++_sp & 255u) == 0u) { if (xb_ld(&(bar)[XB_TMO])) break; if (_sp > XB_SPIN_CAP) { atomicAdd(&(bar)[XB_TMO], 1u); break; } } } } while (0)
struct XcdBarrier { unsigned* bar; unsigned x; volatile LAS unsigned* st; };
__device__ __forceinline__ XcdBarrier xcd_barrier_post(unsigned* bar, volatile LAS unsigned* st) {
    XcdBarrier b; b.bar = bar; b.x = xb_xcc_id(); b.st = st;
    if (threadIdx.x == 0) (void)xb_add(&bar[XB_XCNT(b.x)], 1u);
    return b;
}
__device__ __forceinline__ void xcd_barrier_complete(unsigned* bar, unsigned x, unsigned& nloc, unsigned& nx) {
    const unsigned G = gridDim.x * gridDim.y * gridDim.z;
    unsigned sum, cnt, mine, sp = 0u;
    for (;;) {
        sum = 0u; cnt = 0u; mine = 0u;
#pragma unroll
        for (unsigned j = 0; j < 16; ++j) { const unsigned c = xb_ld(&bar[XB_XCNT(j)]); sum += c; cnt += (c > 0u) ? 1u : 0u; mine = (j == x) ? c : mine; }
        if (sum == G) break;
        __builtin_amdgcn_s_sleep(1);
        if ((++sp & 255u) == 0u) { if (xb_ld(&bar[XB_TMO])) break; if (sp > XB_SPIN_CAP) { atomicAdd(&bar[XB_TMO], 1u); break; } }
    }
    nloc = mine > 0u ? mine : 1u; nx = cnt > 0u ? cnt : 1u;
}
__device__ __forceinline__ void xcd_barrier(const XcdBarrier& b) {
    asm volatile("s_waitcnt vmcnt(0)" ::: "memory");
    __syncthreads();
    if (threadIdx.x == 0) {
        unsigned* bar = b.bar;
        __builtin_amdgcn_s_waitcnt(0);
        unsigned nloc = b.st[0], nx = b.st[1];
        if (nloc == 0u) { xcd_barrier_complete(bar, b.x, nloc, nx); b.st[0] = nloc; b.st[1] = nx; }
        const unsigned old = xb_add(&bar[XB_XSUB(b.x)], 1u);
        const unsigned gen = old / nloc;
        if (old + 1u == (gen + 1u) * nloc) {
            __builtin_amdgcn_fence(__ATOMIC_RELEASE, "agent");
            asm volatile("s_waitcnt vmcnt(0)" ::: "memory");
            const unsigned og = xb_add(&bar[XB_TOP], 1u);
            const unsigned tg = og / nx;
            if (og + 1u == (tg + 1u) * nx) xb_add(&bar[XB_TOPGEN], 1u);
            else XB_SPIN(xb_ld(&bar[XB_TOPGEN]) == tg, bar);
            __builtin_amdgcn_fence(__ATOMIC_ACQUIRE, "agent");
            xb_add(&bar[XB_XGEN(b.x)], 1u);
            asm volatile("s_waitcnt vmcnt(0)" ::: "memory");
        } else {
            XB_SPIN(xb_ld(&bar[XB_XGEN(b.x)]) == gen, bar);
            __builtin_amdgcn_fence(__ATOMIC_ACQUIRE, "agent");
            asm volatile("s_waitcnt vmcnt(0)" ::: "memory");
        }
    }
    __syncthreads();
}

struct Args { const float* in[22]; float* out; unsigned char* ws; int ph_lo, ph_hi; };
typedef const __attribute__((address_space(4))) Args* KA;
enum { I_X = 0, I_C, I_WADA, I_BADA, I_GF1, I_W1A, I_W3A, I_W2A, I_GMIX, I_WIN, I_SPW, I_SPB, I_GV, I_GQ, I_GK, I_SINKS, I_RELB, I_WOUT, I_GF2, I_W1B, I_W3B, I_W2B };


typedef _Float16 h16x4 __attribute__((ext_vector_type(4)));
typedef _Float16 h16x8 __attribute__((ext_vector_type(8)));
template <int MODE> struct EpiResidK {
    static constexpr bool PERM = true, AFTER_DRAIN = false; static constexpr int REP = (MODE == 2) ? MK_EPI_REP_OUT : 1;
    KA ka;
    __device__ __forceinline__ void prefetch(LAS unsigned char* sl, const pg8::Unit& u, int wr, int wc, int lane) const {
        KA k = ka; asm volatile("" : "+s"(k));
        const float* mod = (const float*)(k->ws + WS_MOD);
        const int col = u.pn * pg8::BM + wc * 32 + (lane & 31) + (lane >> 5) * pg8::HALF; const size_t bo = (size_t)(u.pm / (SEQ / 256)) * MODW;
        const float* gate = mod + (MODE == 0 ? 2 : MODE == 1 ? 5 : 8) * DM + bo + col;
        __builtin_amdgcn_global_load_lds((const unsigned*)gate, (LAS unsigned*)sl, 4, 0, 0);
        if constexpr (MODE != 2) {
            const float* g_next = k->in[MODE == 0 ? I_GMIX : I_GF2] + col; const float* sc_next = mod + (MODE == 0 ? 4 : 7) * DM + bo + col;
            __builtin_amdgcn_global_load_lds((const unsigned*)g_next, (LAS unsigned*)(sl + 256), 4, 0, 0);
            __builtin_amdgcn_global_load_lds((const unsigned*)sc_next, (LAS unsigned*)(sl + 512), 4, 0, 0);
        }
    }
    __device__ __forceinline__ void operator()(const pg8::f32x4 (&acc)[2][2][4][2], const pg8::Unit& u, int wr, int wc, int fr, int fq, LAS unsigned char* sl) const {
        using pg8::BM; using pg8::HALF; using pg8::cvt_pk_bf16;
        KA k = ka; asm volatile("" : "+s"(k));
        unsigned char* ws = k->ws;
        constexpr float scale = (MODE == 1) ? 1.0f : 0.5f;
        constexpr bool has_next = (MODE != 2);
        const float* xin = k->in[I_X]; _Float16* XH = (_Float16*)(ws + WS_XH); float* outf = k->out;
        bf16_t* An = (bf16_t*)(ws + WS_H); float* ssq_next = (float*)(ws + WS_SSQ) + (MODE == 0 ? M : 2 * M);
        constexpr int ldc = DM;
        const int col0 = u.pn * BM + wc * 32 + 8 * fq;
        const int rowb = u.pm * BM + wr * 64 + fr;
        constexpr int WIN = (MODE == 0) ? 2 : 4;
        f32x4 bsf[MODE == 0 ? WIN : 1][2][2]; h16x8 bsh[MODE == 0 ? 1 : WIN][2];
#define RES_LOAD(slot, rowidx) do { const size_t o_ = (size_t)(rowidx) * ldc + col0; \
        if constexpr (MODE == 0) { _Pragma("unroll") for (int bj = 0; bj < 2; ++bj) _Pragma("unroll") for (int n = 0; n < 2; ++n) bsf[slot][bj][n] = __builtin_nontemporal_load((const f32x4*)(xin + o_ + bj * HALF + n * 4)); } \
        else { _Pragma("unroll") for (int bj = 0; bj < 2; ++bj) bsh[slot][bj] = *(const h16x8*)(XH + o_ + bj * HALF); } } while (0)
#pragma unroll
        for (int gi = 0; gi < WIN; ++gi) RES_LOAD(gi, rowb + (gi >> 2) * HALF + (gi & 3) * 16);
        const LAS float* sf = (const LAS float*)sl;
        f32x4 gv[2][2], ca[2][2];
#pragma unroll
        for (int bj = 0; bj < 2; ++bj)
#pragma unroll
            for (int n = 0; n < 2; ++n) { gv[bj][n] = *(const LAS f32x4*)(sf + bj * 32 + 8 * fq + 4 * n) * scale;
                if constexpr (has_next) ca[bj][n] = *(const LAS f32x4*)(sf + 64 + bj * 32 + 8 * fq + 4 * n) * (*(const LAS f32x4*)(sf + 128 + bj * 32 + 8 * fq + 4 * n) + 1.0f);
                else ca[bj][n] = (f32x4){0.f, 0.f, 0.f, 0.f}; }
#pragma unroll
        for (int gi = 0; gi < 8; ++gi) { const int ai = gi >> 2, m = gi & 3;
            const int row = rowb + ai * HALF + m * 16; const size_t off = (size_t)row * ldc + col0;
            float sq = 0.f;
#pragma unroll
            for (int bj = 0; bj < 2; ++bj) { f32x4 o[2];
#pragma unroll
                for (int n = 0; n < 2; ++n) { f32x4 bv;
                    if constexpr (MODE == 0) bv = bsf[gi % WIN][bj][n];
                    else { const h16x8 hh = bsh[gi % WIN][bj]; bv = (f32x4){(float)hh[4 * n], (float)hh[4 * n + 1], (float)hh[4 * n + 2], (float)hh[4 * n + 3]}; }
                    o[n] = bv + gv[bj][n] * acc[ai][bj][m][n];
                    if constexpr (MODE == 2) *(f32x4*)(outf + off + bj * HALF + n * 4) = o[n];
                    sq += (o[n][0] * o[n][0] + o[n][1] * o[n][1]) + (o[n][2] * o[n][2] + o[n][3] * o[n][3]); }
                if constexpr (has_next) {
                    h16x8 xh;
#pragma unroll
                    for (int e = 0; e < 4; ++e) { xh[e] = (_Float16)o[0][e]; xh[4 + e] = (_Float16)o[1][e]; }
                    *(h16x8*)(XH + off + bj * HALF) = xh;
                    const f32x4 h0 = o[0] * ca[bj][0], h1 = o[1] * ca[bj][1];
                    u32x4 w; w.x = cvt_pk_bf16(h0[0], h0[1]); w.y = cvt_pk_bf16(h0[2], h0[3]); w.z = cvt_pk_bf16(h1[0], h1[1]); w.w = cvt_pk_bf16(h1[2], h1[3]);
                    *(u32x4*)(An + off + bj * HALF) = w; } }
            if constexpr (has_next) { sq += __shfl_xor(sq, 16); sq += __shfl_xor(sq, 32); if (fq == 0) atomicAdd(ssq_next + row, sq); }
            if (gi + WIN < 8) RES_LOAD(gi % WIN, rowb + ((gi + WIN) >> 2) * HALF + ((gi + WIN) & 3) * 16);
            asm volatile("" ::: "memory");
        }
#undef RES_LOAD
    }
};

__device__ __forceinline__ void conv_item(const float* W, int K, int N, bf16_t* WT, int kb, int n0, int dst_row0, LAS float* scr, int lane) {
    const int k0 = 64 * kb;
#pragma unroll 8
    for (int i = 0; i < 32; ++i) { const int kk = 2 * i + (lane >> 5); scr[kk * 33 + (lane & 31)] = __builtin_nontemporal_load(W + (size_t)(k0 + kk) * N + n0 + (lane & 31)); }
    LDS_WAIT(); asm volatile("" ::: "memory");
    const int c = lane & 7;
#pragma unroll
    for (int j = 0; j < 4; ++j) { const int n = (lane >> 3) + 8 * j; const LAS float* s = scr + (8 * c) * 33 + n;
        u32x4 o; o.x = pk2(s[0 * 33], s[1 * 33]); o.y = pk2(s[2 * 33], s[3 * 33]); o.z = pk2(s[4 * 33], s[5 * 33]); o.w = pk2(s[6 * 33], s[7 * 33]);
        *(u32x4*)(WT + (size_t)(dst_row0 + n) * K + k0 + 8 * c) = o; }
    LDS_WAIT(); asm volatile("" ::: "memory");
}
__device__ __forceinline__ void conv_dispatch(KA a, int it, LAS float* scr, int lane) {
    unsigned char* ws = a->ws;
    constexpr int I_FF = (DM / 64) * (DFF / 32);
    constexpr int I_DN = (DFF / 64) * (DM / 32);
    constexpr int I_IN = (DM / 64) * (INC / 32);
    constexpr int I_OUT = (DM / 64) * (DM / 32);
    int r = it;
#define CONV_LAYER(W1I, W3I, W2I, WS13, WS2) { \
        bf16_t* W13 = (bf16_t*)(ws + (WS13)); bf16_t* W2 = (bf16_t*)(ws + (WS2)); \
        if (r < I_FF) { const int nblk = DFF / 32, kb = r / nblk, n0 = (r % nblk) * 32; conv_item(a->in[W1I], DM, DFF, W13, kb, n0, (n0 >> 7) * 256 + (n0 & 127), scr, lane); return; } r -= I_FF; \
        if (r < I_FF) { const int nblk = DFF / 32, kb = r / nblk, n0 = (r % nblk) * 32; conv_item(a->in[W3I], DM, DFF, W13, kb, n0, (n0 >> 7) * 256 + 128 + (n0 & 127), scr, lane); return; } r -= I_FF; \
        if (r < I_DN) { const int nblk = DM / 32, kb = r / nblk, n0 = (r % nblk) * 32; conv_item(a->in[W2I], DFF, DM, W2, kb, n0, n0, scr, lane); return; } r -= I_DN; }
    CONV_LAYER(I_W1A, I_W3A, I_W2A, WS_W13A, WS_W2A)
    CONV_LAYER(I_W1B, I_W3B, I_W2B, WS_W13B, WS_W2B)
#undef CONV_LAYER
    if (r < I_IN) { const int nblk = INC / 32, kb = r / nblk, n0 = (r % nblk) * 32; conv_item(a->in[I_WIN], DM, INC, (bf16_t*)(ws + WS_WIN), kb, n0, n0, scr, lane); return; } r -= I_IN;
    if (r < I_OUT) { const int nblk = DM / 32, kb = r / nblk, n0 = (r % nblk) * 32; conv_item(a->in[I_WOUT], DM, DM, (bf16_t*)(ws + WS_WOUT), kb, n0, n0, scr, lane); return; }
}
constexpr int N_CONV_ITEMS = 6 * 5632 + 3328 + 2048;
constexpr int N_MODCG = MODW / 256;
constexpr int N_MOD_ITEMS = N_MODCG * NKC;

__device__ __forceinline__ void mod_item(KA a, int it, LAS float* scr, int lane) {
    const int cgp = it % N_MODCG, kc = it / N_MODCG, k0 = kc * KCH;
    const float* c = a->in[I_C];
    { const int kk = lane & 31, bh = lane >> 5;
#pragma unroll
      for (int bb = 0; bb < 2; ++bb) { const int b = bh * 2 + bb; const float v = c[b * DM + k0 + kk]; scr[b * 32 + kk] = v / (1.0f + __expf(-v)); } }
    LDS_WAIT(); asm volatile("" ::: "memory");
    const float* wp = a->in[I_WADA] + (size_t)k0 * MODW + cgp * 256 + lane * 4;
    f32x4 acc[4] = {{0.f, 0.f, 0.f, 0.f}, {0.f, 0.f, 0.f, 0.f}, {0.f, 0.f, 0.f, 0.f}, {0.f, 0.f, 0.f, 0.f}};
#pragma unroll 8
    for (int kk = 0; kk < KCH; ++kk) { const f32x4 w = __builtin_nontemporal_load((const f32x4*)(wp + (size_t)kk * MODW));
#pragma unroll
        for (int b = 0; b < 4; ++b) acc[b] += w * scr[b * 32 + kk]; }
    float* part = (float*)(a->ws + WS_PART);
#pragma unroll
    for (int b = 0; b < 4; ++b) *(f32x4*)(part + (size_t)(kc * 4 + b) * MODW + cgp * 256 + lane * 4) = acc[b];
    LDS_WAIT(); asm volatile("" ::: "memory");
}

__device__ __forceinline__ void prologue_pass(const float* X, const float* g, const float* mod, int sc_idx, bf16_t* H, float* ssq, int gw, int ngw, int lane) {
    const int rpw = M / ngw;
    const int row0 = gw * rpw, b = row0 / SEQ;
    const f32x4* g4 = (const f32x4*)g + lane; const f32x4* sc4 = (const f32x4*)(mod + (size_t)b * MODW + sc_idx * DM) + lane;
    f32x4 ca[8];
#pragma unroll
    for (int j = 0; j < 8; ++j) ca[j] = g4[64 * j] * (sc4[64 * j] + 1.0f);
    f32x4 vn[8];
    { const f32x4* xr = (const f32x4*)(X + (size_t)row0 * DM) + lane;
#pragma unroll
      for (int j = 0; j < 8; ++j) vn[j] = __builtin_nontemporal_load(xr + 64 * j); }
    for (int rr = 0; rr < rpw; ++rr) {
        const int row = row0 + rr;
        f32x4 v[8]; float s = 0.f;
#pragma unroll
        for (int j = 0; j < 8; ++j) v[j] = vn[j];
        { const f32x4* xr = (const f32x4*)(X + (size_t)(rr + 1 < rpw ? row + 1 : row) * DM) + lane;
#pragma unroll
          for (int j = 0; j < 8; ++j) vn[j] = __builtin_nontemporal_load(xr + 64 * j); }
#pragma unroll
        for (int j = 0; j < 8; ++j) s += (v[j].x * v[j].x + v[j].y * v[j].y) + (v[j].z * v[j].z + v[j].w * v[j].w);
        u32x2* o8 = (u32x2*)(H + (size_t)row * DM) + lane;
#pragma unroll
        for (int j = 0; j < 8; ++j) { const f32x4 h = v[j] * ca[j]; u32x2 w; w.x = pk2(h.x, h.y); w.y = pk2(h.z, h.w); o8[64 * j] = w; }
        s = wave_sum(s);
        if (lane == 0) ssq[row] = s;
    }
}
__device__ __forceinline__ void bias_gemv(const bf16_t* W, int N, const float* shift, float* out, int gw, int ngw, int lane) {
    f32x4 cb[4][4][2];
#pragma unroll
    for (int b = 0; b < 4; ++b)
#pragma unroll
        for (int j = 0; j < 4; ++j) { const float* p = shift + (size_t)b * MODW + 8 * (lane + 64 * j); cb[b][j][0] = *(const f32x4*)p; cb[b][j][1] = *(const f32x4*)(p + 4); }
    for (int n = gw; n < N; n += 2 * ngw) {
        const int n1 = n + ngw; const bool has1 = n1 < N;
        const u32x4* wp0 = (const u32x4*)(W + (size_t)n * DM) + lane; const u32x4* wp1 = (const u32x4*)(W + (size_t)(has1 ? n1 : n) * DM) + lane;
        u32x4 w[2][4];
#pragma unroll
        for (int j = 0; j < 4; ++j) { w[0][j] = wp0[64 * j]; w[1][j] = wp1[64 * j]; }
#pragma unroll
        for (int rr = 0; rr < 2; ++rr) {
            float acc[4] = {0.f, 0.f, 0.f, 0.f};
#pragma unroll
            for (int j = 0; j < 4; ++j) { const f32x4 w0 = (f32x4){bflo(w[rr][j].x), bfhi(w[rr][j].x), bflo(w[rr][j].y), bfhi(w[rr][j].y)}, w1 = (f32x4){bflo(w[rr][j].z), bfhi(w[rr][j].z), bflo(w[rr][j].w), bfhi(w[rr][j].w)};
#pragma unroll
                for (int b = 0; b < 4; ++b) { const f32x4 p = w0 * cb[b][j][0] + w1 * cb[b][j][1]; acc[b] += (p.x + p.y) + (p.z + p.w); } }
            const int nn = rr ? n1 : n;
#pragma unroll
            for (int b = 0; b < 4; ++b) { const float t = wave_sum(acc[b]); if (lane == 0 && (rr == 0 || has1)) out[(size_t)b * N + nn] = t; }
        }
    }
}

constexpr int GW_STR = 136;
__device__ __forceinline__ void gmlp_phase(KA a, LAS unsigned char* lds, int bid, int tid, int wid, int lane) {
    const int h = bid & 7;
    LAS bf16_t* Wl = (LAS bf16_t*)lds;
    LAS bf16_t* Vt = (LAS bf16_t*)(lds + 128 * GW_STR * 2);
    const bf16_t* Z = (const bf16_t*)(a->ws + WS_U); bf16_t* Y = (bf16_t*)(a->ws + WS_Y);
    const int r = lane & 15, q = lane >> 4;
    { const int i = tid >> 2, qd = tid & 3; const float* src = a->in[I_SPW] + ((size_t)h * 128 + i) * 128 + qd * 32;
#pragma unroll
      for (int k = 0; k < 4; ++k) { const f32x4 x0 = *(const f32x4*)(src + 8 * k), x1 = *(const f32x4*)(src + 8 * k + 4); const int j0 = qd * 32 + 8 * k;
          float e[8] = {x0.x, x0.y, x0.z, x0.w, x1.x, x1.y, x1.z, x1.w};
#pragma unroll
          for (int t = 0; t < 8; ++t) e[t] = (j0 + t <= i) ? e[t] : 0.f;
          u32x4 o; o.x = pk2(e[0], e[1]); o.y = pk2(e[2], e[3]); o.z = pk2(e[4], e[5]); o.w = pk2(e[6], e[7]);
          *(LAS u32x4*)(Wl + i * GW_STR + j0) = o; } }
    const int sj = tid >> 2, sqd = tid & 3;
    const int gi_ = 16 * wid + r; const float sb = a->in[I_SPB][h * 128 + gi_];
    float gvr[32];
#pragma unroll
    for (int e = 0; e < 32; ++e) gvr[e] = a->in[I_GV][h * 128 + sqd * 32 + e];
    u32x4 raw[4]; u32x2 ur[8];
    { const int combo = (bid >> 3); const size_t R0 = (size_t)(combo >> 6) * SEQ + (size_t)(combo & 63) * 128;
      const bf16_t* src = Z + (R0 + sj) * INC + AW + h * 128 + sqd * 32;
#pragma unroll
      for (int k = 0; k < 4; ++k) raw[k] = *(const u32x4*)(src + 8 * k);
      const bf16_t* up = Z + (R0 + gi_) * INC + h * 128 + 4 * q;
#pragma unroll
      for (int dt = 0; dt < 8; ++dt) ur[dt] = *(const u32x2*)(up + 16 * dt); }
    for (int it = 0; it < 8; ++it) {
        const int combo = (bid >> 3) + 32 * it; const size_t R0 = (size_t)(combo >> 6) * SEQ + (size_t)(combo & 63) * 128;
        const int combo1 = (bid >> 3) + 32 * (it < 7 ? it + 1 : it); const size_t R1 = (size_t)(combo1 >> 6) * SEQ + (size_t)(combo1 & 63) * 128;
        __syncthreads();
        { float v[32]; float ss = 0.f;
#pragma unroll
          for (int k = 0; k < 4; ++k) { v[8 * k + 0] = bflo(raw[k].x); v[8 * k + 1] = bfhi(raw[k].x); v[8 * k + 2] = bflo(raw[k].y); v[8 * k + 3] = bfhi(raw[k].y);
              v[8 * k + 4] = bflo(raw[k].z); v[8 * k + 5] = bfhi(raw[k].z); v[8 * k + 6] = bflo(raw[k].w); v[8 * k + 7] = bfhi(raw[k].w); }
          { const bf16_t* src = Z + (R1 + sj) * INC + AW + h * 128 + sqd * 32;
#pragma unroll
            for (int k = 0; k < 4; ++k) raw[k] = *(const u32x4*)(src + 8 * k); }
#pragma unroll
          for (int e = 0; e < 32; ++e) ss += v[e] * v[e];
          ss += __shfl_xor(ss, 1); ss += __shfl_xor(ss, 2);
          const float rstd = 1.0f / sqrtf(ss * (1.0f / 128.0f) + EPS);
#pragma unroll
          for (int e = 0; e < 32; ++e) Vt[(sqd * 32 + e) * GW_STR + sj] = (bf16_t)f2bf(v[e] * rstd * gvr[e]); }
        __syncthreads();
        f32x4 acc[8];
#pragma unroll
        for (int dt = 0; dt < 8; ++dt) acc[dt] = (f32x4){0.f, 0.f, 0.f, 0.f};
        const int nks = (wid >> 1) + 1;
        for (int ks = 0; ks < nks; ++ks) {
            const bf16x8 bfr = *(const LAS bf16x8*)(Wl + (16 * wid + r) * GW_STR + 32 * ks + 8 * q);
#pragma unroll
            for (int dt = 0; dt < 8; ++dt) { const bf16x8 afr = *(const LAS bf16x8*)(Vt + (16 * dt + r) * GW_STR + 32 * ks + 8 * q);
                acc[dt] = __builtin_amdgcn_mfma_f32_16x16x32_bf16(afr, bfr, acc[dt], 0, 0, 0); }
        }
        bf16_t* yp = Y + (R0 + gi_) * DM + h * 128 + 4 * q;
#pragma unroll
        for (int dt = 0; dt < 8; ++dt) { const u32x2 uu = ur[dt];
            u32x2 o; o.x = pk2(bflo(uu.x) * (acc[dt][0] + sb), bfhi(uu.x) * (acc[dt][1] + sb)); o.y = pk2(bflo(uu.y) * (acc[dt][2] + sb), bfhi(uu.y) * (acc[dt][3] + sb));
            *(u32x2*)(yp + 16 * dt) = o; }
        { const bf16_t* up = Z + (R1 + gi_) * INC + h * 128 + 4 * q;
#pragma unroll
          for (int dt = 0; dt < 8; ++dt) ur[dt] = *(const u32x2*)(up + 16 * dt); }
    }
}

constexpr int KL_STR = 72, VT_STR = 264;
__device__ __forceinline__ int t5_bucket(int n) { if (n < 16) return n; const float v = logf((float)n * (1.0f / 16.0f)) / 2.0794415416798357f * 16.0f; const int l = 16 + (int)v; return l < 31 ? l : 31; }
__device__ __forceinline__ void attn_phase(KA a, LAS unsigned char* lds, int bid, int nblk, int tid, int wid, int lane) {
    LAS bf16_t* Kl = (LAS bf16_t*)lds;
    LAS bf16_t* Vt = (LAS bf16_t*)(lds + 256 * KL_STR * 2);
    LAS float* tb = (LAS float*)(lds + 256 * KL_STR * 2 + 64 * VT_STR * 2);
    const bf16_t* Z = (const bf16_t*)(a->ws + WS_U); bf16_t* Y = (bf16_t*)(a->ws + WS_Y);
    const int r = lane & 15, q = lane >> 4;
    const float NEG = -__builtin_inff();
    constexpr float SC = 0.125f * LOG2E;
    for (int unit = bid; unit < 512; unit += nblk) {
        const int kvh = unit & 1, combo = unit >> 1, b = combo >> 6, nb = combo & 63; const size_t R0 = (size_t)b * SEQ + (size_t)nb * 128;
        __syncthreads();
        { const int key = tid >> 1, half = tid & 1; const bool valid = (nb > 0) || (key >= 128);
          u32x4 kr[4], vr[4];
          if (valid) { const bf16_t* kp = Z + (R0 - 128 + key) * INC + 3072 + kvh * 64 + half * 32; const bf16_t* vp = kp + 128;
#pragma unroll
              for (int k = 0; k < 4; ++k) { kr[k] = *(const u32x4*)(kp + 8 * k); vr[k] = *(const u32x4*)(vp + 8 * k); } }
          else {
#pragma unroll
              for (int k = 0; k < 4; ++k) { kr[k] = (u32x4){0u, 0u, 0u, 0u}; vr[k] = (u32x4){0u, 0u, 0u, 0u}; } }
          float kv[32]; float ss = 0.f;
#pragma unroll
          for (int k = 0; k < 4; ++k) { kv[8 * k + 0] = bflo(kr[k].x); kv[8 * k + 1] = bfhi(kr[k].x); kv[8 * k + 2] = bflo(kr[k].y); kv[8 * k + 3] = bfhi(kr[k].y);
              kv[8 * k + 4] = bflo(kr[k].z); kv[8 * k + 5] = bfhi(kr[k].z); kv[8 * k + 6] = bflo(kr[k].w); kv[8 * k + 7] = bfhi(kr[k].w); }
#pragma unroll
          for (int e = 0; e < 32; ++e) ss += kv[e] * kv[e];
          ss += __shfl_xor(ss, 1);
          const float rstd = 1.0f / sqrtf(ss * (1.0f / 64.0f) + EPS);
          const float* gk = a->in[I_GK] + half * 32;
#pragma unroll
          for (int k = 0; k < 4; ++k) { u32x4 o; o.x = pk2(kv[8 * k] * rstd * gk[8 * k], kv[8 * k + 1] * rstd * gk[8 * k + 1]); o.y = pk2(kv[8 * k + 2] * rstd * gk[8 * k + 2], kv[8 * k + 3] * rstd * gk[8 * k + 3]);
              o.z = pk2(kv[8 * k + 4] * rstd * gk[8 * k + 4], kv[8 * k + 5] * rstd * gk[8 * k + 5]); o.w = pk2(kv[8 * k + 6] * rstd * gk[8 * k + 6], kv[8 * k + 7] * rstd * gk[8 * k + 7]);
              *(LAS u32x4*)(Kl + key * KL_STR + half * 32 + 8 * k) = o; }
#pragma unroll
          for (int k = 0; k < 4; ++k) { const unsigned w4[4] = {vr[k].x, vr[k].y, vr[k].z, vr[k].w};
#pragma unroll
              for (int t = 0; t < 4; ++t) { Vt[(half * 32 + 8 * k + 2 * t) * VT_STR + key] = (bf16_t)(w4[t] & 0xffffu); Vt[(half * 32 + 8 * k + 2 * t + 1) * VT_STR + key] = (bf16_t)(w4[t] >> 16); } }
        }
        for (int idx = tid; idx < 1024; idx += NTHREADS) { const int g = idx >> 7, dist = idx & 127; tb[idx] = a->in[I_RELB][t5_bucket(dist) * 16 + kvh * 8 + g] * LOG2E; }
        __syncthreads();
        const int hq = kvh * 8 + wid;
        float breg[9][4];
#pragma unroll
        for (int t = 0; t < 9; ++t)
#pragma unroll
            for (int e = 0; e < 4; ++e) { const int dist = r + 128 - 16 * t - 4 * q - e; breg[t][e] = (dist >= 0 && dist < 128) ? tb[wid * 128 + (dist & 127)] : NEG; }
        const float sink2 = a->in[I_SINKS][hq] * LOG2E;
        float gq[2][8];
#pragma unroll
        for (int ks = 0; ks < 2; ++ks)
#pragma unroll
            for (int e = 0; e < 8; ++e) gq[ks][e] = a->in[I_GQ][32 * ks + 8 * q + e];
        u32x4 qn0, qn1;
        { const bf16_t* qp = Z + (R0 + r) * INC + 2 * AW + hq * 64 + 8 * q; qn0 = *(const u32x4*)qp; qn1 = *(const u32x4*)(qp + 32); }
        for (int c = 0; c < 8; ++c) {
            const u32x4 q0 = qn0, q1 = qn1;
            { const bf16_t* qp = Z + (R0 + 16 * (c < 7 ? c + 1 : c) + r) * INC + 2 * AW + hq * 64 + 8 * q; qn0 = *(const u32x4*)qp; qn1 = *(const u32x4*)(qp + 32); }
            float qv[2][8] = {{bflo(q0.x), bfhi(q0.x), bflo(q0.y), bfhi(q0.y), bflo(q0.z), bfhi(q0.z), bflo(q0.w), bfhi(q0.w)},
                              {bflo(q1.x), bfhi(q1.x), bflo(q1.y), bfhi(q1.y), bflo(q1.z), bfhi(q1.z), bflo(q1.w), bfhi(q1.w)}};
            float ss = 0.f;
#pragma unroll
            for (int ks = 0; ks < 2; ++ks)
#pragma unroll
                for (int e = 0; e < 8; ++e) ss += qv[ks][e] * qv[ks][e];
            ss += __shfl_xor(ss, 16); ss += __shfl_xor(ss, 32);
            const float rstd = 1.0f / sqrtf(ss * (1.0f / 64.0f) + EPS);
            bf16x8 qf[2];
#pragma unroll
            for (int ks = 0; ks < 2; ++ks) { u32x4 o; o.x = pk2(qv[ks][0] * rstd * gq[ks][0], qv[ks][1] * rstd * gq[ks][1]); o.y = pk2(qv[ks][2] * rstd * gq[ks][2], qv[ks][3] * rstd * gq[ks][3]);
                o.z = pk2(qv[ks][4] * rstd * gq[ks][4], qv[ks][5] * rstd * gq[ks][5]); o.w = pk2(qv[ks][6] * rstd * gq[ks][6], qv[ks][7] * rstd * gq[ks][7]); qf[ks] = __builtin_bit_cast(bf16x8, o); }
            f32x4 sacc[9];
#pragma unroll
            for (int t = 0; t < 9; ++t) { sacc[t] = (f32x4){0.f, 0.f, 0.f, 0.f};
#pragma unroll
                for (int ks = 0; ks < 2; ++ks) { const bf16x8 kf = *(const LAS bf16x8*)(Kl + (16 * (c + t) + r) * KL_STR + 32 * ks + 8 * q);
                    sacc[t] = __builtin_amdgcn_mfma_f32_16x16x32_bf16(kf, qf[ks], sacc[t], 0, 0, 0); } }
            float mx = sink2;
#pragma unroll
            for (int t = 0; t < 9; ++t) { const bool dead = (nb == 0) && (c + t < 8);
#pragma unroll
                for (int e = 0; e < 4; ++e) { float s = sacc[t][e] * SC + breg[t][e]; s = dead ? NEG : s; sacc[t][e] = s; mx = fmaxf(mx, s); } }
            mx = fmaxf(mx, __shfl_xor(mx, 16)); mx = fmaxf(mx, __shfl_xor(mx, 32));
            float l = 0.f;
#pragma unroll
            for (int t = 0; t < 9; ++t)
#pragma unroll
                for (int e = 0; e < 4; ++e) { const float p = __builtin_amdgcn_exp2f(sacc[t][e] - mx); sacc[t][e] = p; l += p; }
            l += __shfl_xor(l, 16); l += __shfl_xor(l, 32);
            l += __builtin_amdgcn_exp2f(sink2 - mx);
            const float inv = 1.0f / l;
            f32x4 o[4];
#pragma unroll
            for (int dt = 0; dt < 4; ++dt) o[dt] = (f32x4){0.f, 0.f, 0.f, 0.f};
#pragma unroll
            for (int kk = 0; kk < 5; ++kk) {
                u32x4 pw; pw.x = pk2(sacc[2 * kk][0], sacc[2 * kk][1]); pw.y = pk2(sacc[2 * kk][2], sacc[2 * kk][3]);
                if (kk < 4) { pw.z = pk2(sacc[(2 * kk + 1) % 9][0], sacc[(2 * kk + 1) % 9][1]); pw.w = pk2(sacc[(2 * kk + 1) % 9][2], sacc[(2 * kk + 1) % 9][3]); } else { pw.z = 0u; pw.w = 0u; }
                const bf16x8 pf = __builtin_bit_cast(bf16x8, pw);
#pragma unroll
                for (int dt = 0; dt < 4; ++dt) { const LAS bf16_t* vp = Vt + (16 * dt + r) * VT_STR + 16 * (c + 2 * kk) + 4 * q;
                    u32x4 av; const u32x2 lo = *(const LAS u32x2*)vp; av.x = lo.x; av.y = lo.y;
                    if (kk < 4) { const u32x2 hi = *(const LAS u32x2*)(vp + 16); av.z = hi.x; av.w = hi.y; } else { av.z = 0u; av.w = 0u; }
                    o[dt] = __builtin_amdgcn_mfma_f32_16x16x32_bf16(__builtin_bit_cast(bf16x8, av), pf, o[dt], 0, 0, 0); }
            }
            bf16_t* yp = Y + (R0 + 16 * c + r) * DM + AW + hq * 64 + 4 * q;
#pragma unroll
            for (int dt = 0; dt < 4; ++dt) { u32x2 w; w.x = pk2(o[dt][0] * inv, o[dt][1] * inv); w.y = pk2(o[dt][2] * inv, o[dt][3] * inv); *(u32x2*)(yp + 16 * dt) = w; }
        }
    }
}

static constexpr int SCHED_HOST[] = {MK_SCHED};
constexpr int NPH = (int)(sizeof(SCHED_HOST) / sizeof(int));
__global__ void __launch_bounds__(NTHREADS, 2) fwd_megakernel(Args args) {
    extern __shared__ __attribute__((aligned(16))) unsigned char lds_raw[];
    LAS unsigned char* lds = (LAS unsigned char*)lds_raw;
    KA ka0 = (KA)__builtin_amdgcn_kernarg_segment_ptr();
    const int ph_lo = ka0->ph_lo, ph_hi = ka0->ph_hi;
    const int wid0 = __builtin_amdgcn_readfirstlane(threadIdx.x >> 6);
    volatile LAS unsigned* misc = (volatile LAS unsigned*)(lds + 131072);
    if (threadIdx.x < 64) misc[threadIdx.x] = 0u;
    __syncthreads();
    XcdBarrier xbar = xcd_barrier_post((unsigned*)(ka0->ws + WS_BAR), misc);
    bool xbar_posted = (ph_hi >= 0);
    static constexpr int SCHED[] = {MK_SCHED};
    constexpr int NS = (int)(sizeof(SCHED) / sizeof(int));
    for (int si = ph_lo; si < ph_hi; ++si) {
        const int ph = SCHED[si];
        KA ka = ka0; asm volatile("" : "+s"(ka));
        int wid_s = wid0; asm volatile("" : "+s"(wid_s));
        int tid = wid_s * 64 + (int)__builtin_amdgcn_mbcnt_hi(~0u, __builtin_amdgcn_mbcnt_lo(~0u, 0u)); asm volatile("" : "+v"(tid));
        int bid = blockIdx.x, G = gridDim.x; asm volatile("" : "+s"(bid), "+s"(G));
        const int lane = tid & 63, wid = __builtin_amdgcn_readfirstlane(tid >> 6);
        const int gw = bid * NWAVES + wid, ngw = G * NWAVES;
        unsigned char* ws = ka->ws;
        float* mod = (float*)(ws + WS_MOD);
        bf16_t* H = (bf16_t*)(ws + WS_H); bf16_t* Y = (bf16_t*)(ws + WS_Y); bf16_t* U = (bf16_t*)(ws + WS_U);
        switch (ph) {
        case 0: {
            LAS float* scr = (LAS float*)(lds + wid * 16384);
            for (int it = gw; it < N_CONV_ITEMS + N_MOD_ITEMS; it += ngw) {
                if (it < N_MOD_ITEMS) mod_item(ka, it, scr, lane); else conv_dispatch(ka, it - N_MOD_ITEMS, scr, lane);
            }
        } break;
        case 1: {
            const float* part = (const float*)(ws + WS_PART); const float* bada = ka->in[I_BADA];
            for (int o = bid * NTHREADS + tid; o < BATCH * MODW; o += G * NTHREADS) { const int b = o / MODW, n = o % MODW; float s = bada[n];
#pragma unroll 8
                for (int kc = 0; kc < NKC; ++kc) s += part[(size_t)(kc * 4 + b) * MODW + n];
                mod[o] = s; }
        } break;
        case 2: {
            float* ssq = (float*)(ws + WS_SSQ); float* b2 = (float*)(ws + WS_B2);
            prologue_pass(ka->in[I_X], ka->in[I_GF1], mod, 1, H, ssq, gw, ngw, lane);
            bias_gemv((const bf16_t*)(ws + WS_W13A), 2 * DFF, mod + 0 * DM, b2, gw, ngw, lane);
            bias_gemv((const bf16_t*)(ws + WS_WIN), INC, mod + 3 * DM, b2 + 4 * 2 * DFF, gw, ngw, lane);
            bias_gemv((const bf16_t*)(ws + WS_W13B), 2 * DFF, mod + 6 * DM, b2 + 4 * 2 * DFF + 4 * INC, gw, ngw, lane);
            for (int i = bid * NTHREADS + tid; i < 2 * M; i += G * NTHREADS) ssq[M + i] = 0.f;
        } break;
        case 3: case 10: {
            const bool first = (ph == 3);
            pg8::Gemm g{H, (const bf16_t*)(ws + (first ? WS_W13A : WS_W13B)), M, 2 * DFF, DM}; pg8::StaticOrder S; S.init(M, 2 * DFF, G, bid);
            pg8::EpiSwiGLU E{U, DFF, (const float*)(ws + WS_SSQ) + (first ? 0 : 2 * M), (const float*)(ws + WS_B2) + (first ? 0 : 4 * 2 * DFF + 4 * INC), 2 * DFF, SEQ / 256};
            pg8::gemm_phase<pg8::EpiSwiGLU, pg8::StaticOrder, true, true>(lds, g, S, E, tid);
        } break;
        case 4: {
            pg8::Gemm g{U, (const bf16_t*)(ws + WS_W2A), M, DM, DFF}; pg8::StaticOrder S; S.init(M, DM, G, bid);
            EpiResidK<0> E{ka0};
            pg8::gemm_phase<EpiResidK<0>, pg8::StaticOrder, true, true>(lds, g, S, E, tid);
        } break;
        case 8: {
            pg8::Gemm g{Y, (const bf16_t*)(ws + WS_WOUT), M, DM, DM}; pg8::StaticOrder S; S.init(M, DM, G, bid);
            EpiResidK<1> E{ka0};
            pg8::gemm_phase<EpiResidK<1>, pg8::StaticOrder, true, true>(lds, g, S, E, tid);
        } break;
        case 11: {
            pg8::Gemm g{U, (const bf16_t*)(ws + WS_W2B), M, DM, DFF}; pg8::StaticOrder S; S.init(M, DM, G, bid);
            EpiResidK<2> E{ka0};
            pg8::gemm_phase<EpiResidK<2>, pg8::StaticOrder, true, true>(lds, g, S, E, tid);
        } break;
        case 6: {
            pg8::Gemm g{H, (const bf16_t*)(ws + WS_WIN), M, INC, DM}; pg8::StaticOrder S; S.init(M, INC, G, bid);
            pg8::EpiZ E{U, INC, 8, (const float*)(ws + WS_SSQ) + M, (const float*)(ws + WS_B2) + 4 * 2 * DFF, INC, SEQ / 256};
            pg8::gemm_phase<pg8::EpiZ, pg8::StaticOrder, true, true>(lds, g, S, E, tid);
        } break;
        case 7: {
            gmlp_phase(ka, lds, bid, tid, wid, lane);
            attn_phase(ka, lds, bid, G, tid, wid, lane);
        } break;
        default: break;
        }
        if (si + 1 < ph_hi) {
            for (int rep = 0; rep < MK_SYNC_REPEAT; ++rep) {
                if (!xbar_posted) { cg::this_grid().sync(); xbar = xcd_barrier_post((unsigned*)(ka0->ws + WS_BAR), misc); xbar_posted = true; }
                else xcd_barrier(xbar);
            }
        }
    }
}

extern "C" void kernel_launch(void* const* d_in, const int* in_sizes, int n_in, void* d_out, int out_size, void* d_ws, size_t ws_size, hipStream_t stream) {
    static int grid = 0;
    if (grid == 0) {
        if (n_in != 22 || out_size != M * DM || ws_size < WS_END) { fprintf(stderr, "kernel_launch: unexpected shapes (n_in %d out %d ws %zu)\n", n_in, out_size, ws_size); grid = -1; return; }
        int dev = 0, cus = 0, per_cu = 0;
        (void)hipGetDevice(&dev); (void)hipDeviceGetAttribute(&cus, hipDeviceAttributeMultiprocessorCount, dev);
        if (hipFuncSetAttribute((const void*)fwd_megakernel, hipFuncAttributeMaxDynamicSharedMemorySize, LDS_BYTES) != hipSuccess) { fprintf(stderr, "kernel_launch: hipFuncSetAttribute failed\n"); grid = -1; return; }
        if (hipOccupancyMaxActiveBlocksPerMultiprocessor(&per_cu, (const void*)fwd_megakernel, NTHREADS, LDS_BYTES) != hipSuccess || per_cu < 1) { fprintf(stderr, "kernel_launch: occupancy query says %d\n", per_cu); per_cu = 1; }
        (void)hipGetLastError();
        grid = cus;
        if (grid != 256) fprintf(stderr, "kernel_launch: %d CUs (built for 256)\n", grid);
    }
    if (grid < 0) return;
    Args a{};
    for (int i = 0; i < 22; ++i) a.in[i] = (const float*)d_in[i];
    a.out = (float*)d_out; a.ws = (unsigned char*)d_ws;
#if MK_PER_PHASE
    for (int p = 0; p < NPH; ++p) { a.ph_lo = p; a.ph_hi = p + 1; hipLaunchKernelGGL(fwd_megakernel, dim3(grid), dim3(NTHREADS), LDS_BYTES, stream, a); }
#else
    a.ph_lo = 0; a.ph_hi = NPH;
    void* kargs[] = {(void*)&a};
    if (hipMemsetAsync((char*)d_ws + WS_BAR, 0, (size_t)XCD_BAR_WORDS * sizeof(unsigned), stream) != hipSuccess) { fprintf(stderr, "kernel_launch: hipMemsetAsync failed\n"); return; }
    hipError_t e = hipLaunchCooperativeKernel((const void*)fwd_megakernel, dim3(grid), dim3(NTHREADS), kargs, LDS_BYTES, stream);
    if (e != hipSuccess) fprintf(stderr, "kernel_launch: cooperative launch failed: %s (grid %d)\n", hipGetErrorString(e), grid);
#endif
}
```

```cpp
#include <hip/hip_runtime.h>
#include <hip/hip_cooperative_groups.h>
#include <cstdio>
#include <cstdint>
namespace cg = cooperative_groups;

#ifndef MK_SCHED
#define MK_SCHED 0, 1, 2, 3, 4, 6, 7, 8, 10, 11
#endif
#ifndef MK_EPI_REP_UP
#define MK_EPI_REP_UP 1
#endif
#ifndef MK_EPI_REP_OUT
#define MK_EPI_REP_OUT 1
#endif
#ifndef MK_SYNC_REPEAT
#define MK_SYNC_REPEAT 1
#endif
#ifndef MK_PER_PHASE
#define MK_PER_PHASE 0
#endif

namespace pg8 {
#define PG8_LAS __attribute__((address_space(3)))
typedef unsigned short bf16_t;
typedef short bf16x8 __attribute__((ext_vector_type(8)));
typedef float f32x4 __attribute__((ext_vector_type(4)));
typedef float f32x2 __attribute__((ext_vector_type(2)));
typedef unsigned u32x4 __attribute__((ext_vector_type(4)));
typedef unsigned u32x2 __attribute__((ext_vector_type(2)));
constexpr int BM = 256, BK = 64, HALF = 128, HTB = HALF * BK * 2, STAGE_BYTES = 8 * HTB, NXCD = 8, WGM = 4;
constexpr int EPI_LDS_OFF = STAGE_BYTES + 1024;

__host__ __device__ __forceinline__ int lds_byte(int r, int c) { const int st = (r >> 4) * 2 + (c >> 5), rr = r & 15, cc = c & 31, ob = rr * 64 + cc * 2; return st * 1024 + (ob ^ (((ob >> 9) & 1) << 5)); }
__host__ __device__ __forceinline__ void stage_rc(int b, int& R, int& C) { const int st = b / 1024, sb = b % 1024, swz = sb ^ (((sb >> 9) & 1) << 5); R = (st >> 1) * 16 + swz / 64; C = (st & 1) * 32 + (swz % 64) / 2; }
__host__ __device__ __forceinline__ int perm32(int rho) { const int n = rho >> 4, i = rho & 15; return 8 * (i >> 2) + 4 * n + (i & 3); }

struct Unit { int pm, pn; };
struct Gemm { const bf16_t* A; const bf16_t* Bt; int M, N, K; };

struct StaticOrder {
    int nM, nN, nwg, G, c, wgm;
    __host__ __device__ void init(int M, int N, int G_, int c_, int wgm_ = WGM) { nM = M / BM; nN = N / BM; nwg = nM * nN; G = G_; c = c_; wgm = wgm_; }
    __host__ __device__ bool next(int i, Unit& u) const {
        const long L = (long)i * G + c; if (L >= nwg) return false;
        int wgid = (int)L; { const int q = nwg / NXCD, r = nwg % NXCD, xcd = wgid % NXCD, off = wgid / NXCD; wgid = (xcd < r ? xcd * (q + 1) : r * (q + 1) + (xcd - r) * q) + off; }
        const int nig = wgm * nN, gid = wgid / nig, fm = gid * wgm, gsz = (nM - fm) < wgm ? (nM - fm) : wgm;
        u.pm = fm + ((wgid % nig) % gsz); u.pn = (wgid % nig) / gsz; return true;
    }
    __device__ __forceinline__ void a_ready(const Unit&) const {}
    __device__ __forceinline__ void done(const Unit&) const {}
};

__device__ __forceinline__ unsigned cvt_pk_bf16(float lo, float hi) { unsigned r; asm volatile("v_cvt_pk_bf16_f32 %0, %1, %2" : "=v"(r) : "v"(lo), "v"(hi)); return r; }
__device__ __forceinline__ f32x2 gelu_pk(f32x2 v) {
    const f32x2 av = __builtin_elementwise_abs(v), d = av * 0.2316418882f + 1.0f;
    f32x2 t; t.x = __builtin_amdgcn_rcpf(d.x); t.y = __builtin_amdgcn_rcpf(d.y);
    f32x2 q = t * 0.5307027145f + (-0.7265760135f); q = q * t + 0.7107068705f; q = q * t + (-0.142248368f); q = q * t + 0.127414796f; q = q * t;
    const f32x2 s = (v * v) * (-0.72134752044f);
    f32x2 e; e.x = __builtin_amdgcn_exp2f(s.x); e.y = __builtin_amdgcn_exp2f(s.y);
    const f32x2 m = v * (q * e), r = v - m;
    f32x2 o; o.x = v.x < 0.f ? m.x : r.x; o.y = v.y < 0.f ? m.y : r.y; return o;
}
__device__ __forceinline__ f32x2 silu_mul_pk(f32x2 a, f32x2 b) {
    const f32x2 t = a * (-1.4426950408889634f); f32x2 e; e.x = __builtin_amdgcn_exp2f(t.x); e.y = __builtin_amdgcn_exp2f(t.y);
    const f32x2 d = e + 1.0f; f32x2 r; r.x = __builtin_amdgcn_rcpf(d.x); r.y = __builtin_amdgcn_rcpf(d.y);
    return (a * b) * r;
}
__device__ __forceinline__ float silu_f(float a) { return a * __builtin_amdgcn_rcpf(1.0f + __builtin_amdgcn_exp2f(a * -1.4426950408889634f)); }


struct EpiSwiGLU {
    static constexpr bool PERM = true, AFTER_DRAIN = false; static constexpr int REP = MK_EPI_REP_UP;
    bf16_t* O; int ldc; const float* ssq; const float* bias2; int bias_stride; int tiles_per_batch;
    __device__ __forceinline__ void prefetch(PG8_LAS unsigned char* sl, const Unit& u, int wr, int wc, int lane) const {
        const float* sp = ssq + u.pm * BM + wr * 64 + lane;
        __builtin_amdgcn_global_load_lds((const unsigned*)sp, (PG8_LAS unsigned*)sl, 4, 0, 0);
        __builtin_amdgcn_global_load_lds((const unsigned*)(sp + HALF), (PG8_LAS unsigned*)(sl + 256), 4, 0, 0);
        const float* bp = bias2 + (size_t)(u.pm / tiles_per_batch) * bias_stride + u.pn * BM + wc * 32 + (lane & 31) + (lane >> 5) * HALF;
        __builtin_amdgcn_global_load_lds((const unsigned*)bp, (PG8_LAS unsigned*)(sl + 512), 4, 0, 0);
    }
    __device__ __forceinline__ void operator()(const f32x4 (&acc)[2][2][4][2], const Unit& u, int wr, int wc, int fr, int fq, PG8_LAS unsigned char* sl) const {
        const int row0 = u.pm * BM + wr * 64 + fr, col0 = u.pn * HALF + wc * 32 + 8 * fq;
        const PG8_LAS float* sf = (const PG8_LAS float*)sl;
        f32x4 bw[2][2];
#pragma unroll
        for (int bj = 0; bj < 2; ++bj)
#pragma unroll
            for (int n = 0; n < 2; ++n) bw[bj][n] = *(const PG8_LAS f32x4*)(sf + 128 + bj * 32 + 8 * fq + 4 * n);
#pragma unroll
        for (int ai = 0; ai < 2; ++ai)
#pragma unroll
            for (int m = 0; m < 4; ++m) { const int row = row0 + ai * HALF + m * 16; bf16_t* rowp = O + (size_t)row * ldc + col0;
                const float rs = __builtin_amdgcn_rsqf(sf[ai * 64 + m * 16 + fr] * (1.0f / 2048.0f) + 1e-6f);
                const f32x4 a0 = acc[ai][0][m][0] * rs + bw[0][0], a1 = acc[ai][0][m][1] * rs + bw[0][1], b0 = acc[ai][1][m][0] * rs + bw[1][0], b1 = acc[ai][1][m][1] * rs + bw[1][1];
                const f32x2 s0 = silu_mul_pk((f32x2){a0[0], a0[1]}, (f32x2){b0[0], b0[1]}), s1 = silu_mul_pk((f32x2){a0[2], a0[3]}, (f32x2){b0[2], b0[3]});
                const f32x2 s2 = silu_mul_pk((f32x2){a1[0], a1[1]}, (f32x2){b1[0], b1[1]}), s3 = silu_mul_pk((f32x2){a1[2], a1[3]}, (f32x2){b1[2], b1[3]});
                u32x4 w; w.x = cvt_pk_bf16(s0.x, s0.y); w.y = cvt_pk_bf16(s1.x, s1.y); w.z = cvt_pk_bf16(s2.x, s2.y); w.w = cvt_pk_bf16(s3.x, s3.y);
                *(u32x4*)rowp = w; }
    }
};
struct EpiZ {
    static constexpr bool PERM = true, AFTER_DRAIN = false; static constexpr int REP = 1;
    bf16_t* O; int ldc; int gelu_tiles; const float* ssq; const float* bias2; int bias_stride; int tiles_per_batch;
    __device__ __forceinline__ void prefetch(PG8_LAS unsigned char* sl, const Unit& u, int wr, int wc, int lane) const {
        const float* sp = ssq + u.pm * BM + wr * 64 + lane;
        __builtin_amdgcn_global_load_lds((const unsigned*)sp, (PG8_LAS unsigned*)sl, 4, 0, 0);
        __builtin_amdgcn_global_load_lds((const unsigned*)(sp + HALF), (PG8_LAS unsigned*)(sl + 256), 4, 0, 0);
        const float* bp = bias2 + (size_t)(u.pm / tiles_per_batch) * bias_stride + u.pn * BM + wc * 32 + (lane & 31) + (lane >> 5) * HALF;
        __builtin_amdgcn_global_load_lds((const unsigned*)bp, (PG8_LAS unsigned*)(sl + 512), 4, 0, 0);
    }
    __device__ __forceinline__ void operator()(const f32x4 (&acc)[2][2][4][2], const Unit& u, int wr, int wc, int fr, int fq, PG8_LAS unsigned char* sl) const {
        const int row0 = u.pm * BM + wr * 64 + fr, col0 = u.pn * BM + wc * 32 + 8 * fq;
        const bool act = u.pn < gelu_tiles;
        const PG8_LAS float* sf = (const PG8_LAS float*)sl;
        f32x4 bw[2][2];
#pragma unroll
        for (int bj = 0; bj < 2; ++bj)
#pragma unroll
            for (int n = 0; n < 2; ++n) bw[bj][n] = *(const PG8_LAS f32x4*)(sf + 128 + bj * 32 + 8 * fq + 4 * n);
#pragma unroll
        for (int ai = 0; ai < 2; ++ai)
#pragma unroll
            for (int m = 0; m < 4; ++m) { const int row = row0 + ai * HALF + m * 16; bf16_t* rowp = O + (size_t)row * ldc + col0;
                const float rs = __builtin_amdgcn_rsqf(sf[ai * 64 + m * 16 + fr] * (1.0f / 2048.0f) + 1e-6f);
#pragma unroll
                for (int bj = 0; bj < 2; ++bj) { f32x4 v0 = acc[ai][bj][m][0] * rs + bw[bj][0], v1 = acc[ai][bj][m][1] * rs + bw[bj][1];
                    if (act) { f32x2 a = gelu_pk((f32x2){v0[0], v0[1]}), b = gelu_pk((f32x2){v0[2], v0[3]}), c = gelu_pk((f32x2){v1[0], v1[1]}), d = gelu_pk((f32x2){v1[2], v1[3]});
                        v0 = (f32x4){a.x, a.y, b.x, b.y}; v1 = (f32x4){c.x, c.y, d.x, d.y}; }
                    u32x4 w; w.x = cvt_pk_bf16(v0[0], v0[1]); w.y = cvt_pk_bf16(v0[2], v0[3]); w.z = cvt_pk_bf16(v1[0], v1[1]); w.w = cvt_pk_bf16(v1[2], v1[3]);
                    *(u32x4*)(rowp + bj * HALF) = w; } }
    }
};

template <class Epi, class Sched, bool ALIGN_EPI = false, bool SP2 = false>
__device__ __forceinline__ void gemm_phase(PG8_LAS unsigned char* lds, const Gemm g, const Sched& S, const Epi& E, const int tid) {
    const int wid = __builtin_amdgcn_readfirstlane(tid >> 6), lane = tid & 63, wr = wid >> 2, wc = wid & 3, fr = lane & 15, fq = lane >> 4;
    const int K = g.K, nt = K / BK;
    unsigned voffA[2], voffB[2];
#pragma unroll
    for (int i = 0; i < 2; ++i) { int R, C; stage_rc(tid * 16 + i * 8192, R, C); const int Rb = Epi::PERM ? ((R & ~31) + perm32(R & 31)) : R;
        voffA[i] = (unsigned)(R * K + C) * 2u; voffB[i] = (unsigned)(Rb * K + C) * 2u; }
    const size_t kstep = (size_t)(BK * 2);
    const size_t hstep = (size_t)HALF * K * 2;
    const size_t tstep = 2 * hstep;
    const unsigned ldsw = (unsigned)wid * 1024u;
    const int aoff = lds_byte(wr * 64 + fr, fq * 8), boff = lds_byte(wc * 32 + fr, fq * 8);
#define PG8_SA(b, h) (((b) * 2 + (h)) * HTB)
#define PG8_SB(b, h) ((4 + (b) * 2 + (h)) * HTB)
#define PG8_STAGE(bufoff, gbase, voff) do { _Pragma("unroll") for (int _i = 0; _i < 2; ++_i) \
        __builtin_amdgcn_global_load_lds((const unsigned*)((const char*)(gbase) + (voff)[_i]), (PG8_LAS unsigned*)(lds + (bufoff) + ldsw + _i * 8192), 16, 0, 0); } while (0)
#define PG8_LDA(dst, b, h) do { _Pragma("unroll") for (int m = 0; m < 4; ++m) _Pragma("unroll") for (int k = 0; k < 2; ++k) dst[m][k] = *(const PG8_LAS bf16x8*)(lds + PG8_SA(b, h) + aoff + m * 2048 + k * 1024); } while (0)
#define PG8_LDB(dst, b, h) do { _Pragma("unroll") for (int n = 0; n < 2; ++n) _Pragma("unroll") for (int k = 0; k < 2; ++k) dst[n][k] = *(const PG8_LAS bf16x8*)(lds + PG8_SB(b, h) + boff + n * 2048 + k * 1024); } while (0)
#define PG8_MMA(ai, bj, At, Bt) do { __builtin_amdgcn_s_setprio(1); _Pragma("unroll") for (int m = 0; m < 4; ++m) _Pragma("unroll") for (int n = 0; n < 2; ++n) _Pragma("unroll") for (int k = 0; k < 2; ++k) \
        acc[ai][bj][m][n] = __builtin_amdgcn_mfma_f32_16x16x32_bf16(Bt[n][k], At[m][k], acc[ai][bj][m][n], 0, 0, 0); __builtin_amdgcn_s_setprio(0); } while (0)
#define PG8_WAIT_V(n) asm volatile("s_waitcnt vmcnt(" #n ")" ::: "memory")
#define PG8_WAIT_L(n) asm volatile("s_waitcnt lgkmcnt(" #n ")" ::: "memory")
#define PG8_BAR __builtin_amdgcn_s_barrier()
#define PG8_SCHED __builtin_amdgcn_sched_barrier(0)
    Unit cur, nxt; int ui = 0;
    if (!S.next(0, cur)) return;
    f32x4 acc[2][2][4][2];
#pragma unroll
    for (int a = 0; a < 2; ++a)
#pragma unroll
        for (int b = 0; b < 2; ++b)
#pragma unroll
            for (int m = 0; m < 4; ++m)
#pragma unroll
                for (int n = 0; n < 2; ++n) acc[a][b][m][n] = (f32x4){0.f, 0.f, 0.f, 0.f};
    bf16x8 At[4][2], B0[2][2], B1[2][2];
    const char* cA = (const char*)g.A + (size_t)cur.pm * tstep; const char* cB = (const char*)g.Bt + (size_t)cur.pn * tstep;
    S.a_ready(cur);
    if constexpr (SP2) {
        PG8_STAGE(PG8_SB(0, 0), cB, voffB); PG8_STAGE(PG8_SB(0, 1), cB + hstep, voffB); PG8_STAGE(PG8_SA(0, 0), cA, voffA); PG8_STAGE(PG8_SA(0, 1), cA + hstep, voffA);
        if (wr == 1) PG8_BAR;
        PG8_WAIT_V(2); PG8_BAR;
        PG8_STAGE(PG8_SB(1, 0), cB + kstep, voffB); PG8_STAGE(PG8_SA(1, 0), cA + kstep, voffA); PG8_STAGE(PG8_SB(1, 1), cB + hstep + kstep, voffB);
        PG8_WAIT_V(6); PG8_BAR;
    } else {
        PG8_STAGE(PG8_SB(0, 0), cB, voffB); PG8_STAGE(PG8_SA(0, 0), cA, voffA); PG8_STAGE(PG8_SB(0, 1), cB + hstep, voffB); PG8_STAGE(PG8_SA(0, 1), cA + hstep, voffA);
        if (wr == 1) PG8_BAR;
        PG8_WAIT_V(4); PG8_BAR;
        PG8_STAGE(PG8_SB(1, 0), cB + kstep, voffB); PG8_STAGE(PG8_SA(1, 0), cA + kstep, voffA); PG8_STAGE(PG8_SB(1, 1), cB + hstep + kstep, voffB);
        PG8_WAIT_V(6); PG8_BAR;
    }
    for (;;) {
        const bool has_next = S.next(ui + 1, nxt);
        const char* nA = has_next ? (const char*)g.A + (size_t)nxt.pm * tstep : cA; const char* nB = has_next ? (const char*)g.Bt + (size_t)nxt.pn * tstep : cB;
        for (int t = 0; t < nt; t += 2) {
            const bool last = (t == nt - 2);
            const char* a1 = cA + (size_t)(t + 1) * kstep;
            const char* a2 = last ? nA : cA + (size_t)(t + 2) * kstep; const char* b2 = last ? nB : cB + (size_t)(t + 2) * kstep;
            const char* a3 = a2 + kstep; const char* b3 = b2 + kstep;
            if (last && has_next) S.a_ready(nxt);
            if (last) E.prefetch(lds + EPI_LDS_OFF + wid * 1024, cur, wr, wc, lane);
            if constexpr (SP2) {
            PG8_LDB(B0, 0, 0); PG8_LDB(B1, 0, 1); PG8_SCHED; PG8_LDA(At, 0, 0); PG8_STAGE(PG8_SA(1, 1), a1 + hstep, voffA);
            PG8_WAIT_V(8); PG8_WAIT_L(0); PG8_BAR; PG8_MMA(0, 0, At, B0); PG8_MMA(0, 1, At, B1); PG8_BAR; PG8_SCHED;
            PG8_LDA(At, 0, 1); PG8_STAGE(PG8_SB(0, 0), b2, voffB); PG8_STAGE(PG8_SB(0, 1), b2 + hstep, voffB); PG8_STAGE(PG8_SA(0, 0), a2, voffA);
            PG8_WAIT_V(8); PG8_WAIT_L(0); PG8_BAR; PG8_MMA(1, 0, At, B0); PG8_MMA(1, 1, At, B1); PG8_BAR; PG8_SCHED;
            PG8_LDB(B0, 1, 0); PG8_LDB(B1, 1, 1); PG8_SCHED; PG8_LDA(At, 1, 0); PG8_STAGE(PG8_SA(0, 1), a2 + hstep, voffA);
            PG8_WAIT_V(8); PG8_WAIT_L(0); PG8_BAR; PG8_MMA(0, 0, At, B0); PG8_MMA(0, 1, At, B1); PG8_BAR; PG8_SCHED;
            PG8_LDA(At, 1, 1); PG8_STAGE(PG8_SB(1, 0), b3, voffB); PG8_STAGE(PG8_SB(1, 1), b3 + hstep, voffB); PG8_STAGE(PG8_SA(1, 0), a3, voffA);
            PG8_WAIT_V(8); PG8_WAIT_L(0); PG8_BAR; PG8_MMA(1, 0, At, B0); PG8_MMA(1, 1, At, B1); PG8_BAR; PG8_SCHED;
            } else {
            PG8_LDB(B0, 0, 0); PG8_SCHED; PG8_LDA(At, 0, 0); PG8_STAGE(PG8_SA(1, 1), a1 + hstep, voffA);
            PG8_WAIT_L(8); PG8_BAR; PG8_WAIT_L(0); PG8_MMA(0, 0, At, B0); PG8_BAR; PG8_SCHED;
            PG8_LDB(B1, 0, 1); PG8_STAGE(PG8_SB(0, 0), b2, voffB);
            PG8_BAR; PG8_WAIT_L(0); PG8_MMA(0, 1, At, B1); PG8_BAR;
            PG8_LDA(At, 0, 1); PG8_STAGE(PG8_SA(0, 0), a2, voffA);
            PG8_BAR; PG8_WAIT_L(0); PG8_MMA(1, 0, At, B0); PG8_BAR; PG8_SCHED;
            PG8_STAGE(PG8_SB(0, 1), b2 + hstep, voffB);
            PG8_WAIT_V(6); PG8_BAR; PG8_MMA(1, 1, At, B1); PG8_BAR;
            PG8_LDB(B0, 1, 0); PG8_SCHED; PG8_LDA(At, 1, 0); PG8_STAGE(PG8_SA(0, 1), a2 + hstep, voffA);
            PG8_WAIT_L(8); PG8_BAR; PG8_WAIT_L(0); PG8_MMA(0, 0, At, B0); PG8_BAR; PG8_SCHED;
            PG8_LDB(B1, 1, 1); PG8_STAGE(PG8_SB(1, 0), b3, voffB);
            PG8_BAR; PG8_WAIT_L(0); PG8_MMA(0, 1, At, B1); PG8_BAR;
            PG8_LDA(At, 1, 1); PG8_STAGE(PG8_SA(1, 0), a3, voffA);
            PG8_BAR; PG8_WAIT_L(0); PG8_MMA(1, 0, At, B0); PG8_BAR; PG8_SCHED;
            PG8_STAGE(PG8_SB(1, 1), b3 + hstep, voffB);
            PG8_WAIT_V(6); PG8_BAR; PG8_MMA(1, 1, At, B1); PG8_BAR;
            }
        }
        if constexpr (ALIGN_EPI) { if (wr == 0) PG8_BAR; }
        for (int er = 0; er < Epi::REP; ++er) { E(acc, cur, wr, wc, fr, fq, lds + EPI_LDS_OFF + wid * 1024); if (Epi::REP > 1) asm volatile("" ::: "memory"); }
        S.done(cur);
        if (!has_next) break;
#pragma unroll
        for (int a = 0; a < 2; ++a)
#pragma unroll
            for (int b = 0; b < 2; ++b)
#pragma unroll
                for (int m = 0; m < 4; ++m)
#pragma unroll
                    for (int n = 0; n < 2; ++n) acc[a][b][m][n] = (f32x4){0.f, 0.f, 0.f, 0.f};
        cur = nxt; cA = nA; cB = nB; ++ui;
        if constexpr (ALIGN_EPI) { if (wr == 1) PG8_BAR; }
    }
    PG8_WAIT_V(0);
    if constexpr (!ALIGN_EPI) { if (wr == 0) PG8_BAR; }
    PG8_BAR;
#undef PG8_SA
#undef PG8_SB
#undef PG8_STAGE
#undef PG8_LDA
#undef PG8_LDB
#undef PG8_MMA
#undef PG8_WAIT_V
#undef PG8_WAIT_L
#undef PG8_BAR
#undef PG8_SCHED
}
}

constexpr int DM = 2048, BATCH = 4, SEQ = 8192, M = BATCH * SEQ;
constexpr int AW = 1024, BW = 1024, KVW = 128, INC = 3328, DFF = 5632, NMOD = 9;
constexpr int MODW = NMOD * DM;
constexpr float EPS = 1e-6f, LOG2E = 1.4426950408889634f;
constexpr int NWAVES = 8, NTHREADS = 512;
constexpr int LDS_BYTES = 131072 + 1024 + 8192;
constexpr int NKC = 64, KCH = DM / NKC;

constexpr size_t MiB = 1u << 20;
constexpr size_t WS_MOD = 0;
constexpr size_t WS_BAR = 512 * 1024;
constexpr size_t WS_PART = 1 * MiB;
constexpr size_t WS_SSQ = 20 * MiB;
constexpr size_t WS_B2 = 21 * MiB;
constexpr size_t WS_W13A = 24 * MiB;
constexpr size_t WS_W2A = 68 * MiB;
constexpr size_t WS_WIN = 90 * MiB;
constexpr size_t WS_WOUT = 103 * MiB;
constexpr size_t WS_W13B = 111 * MiB;
constexpr size_t WS_W2B = 155 * MiB;
constexpr size_t WS_H = 177 * MiB;
constexpr size_t WS_Y = 305 * MiB;
constexpr size_t WS_U = 433 * MiB;
constexpr size_t WS_XH = 785 * MiB;
constexpr size_t WS_END = 913 * MiB;

typedef unsigned short bf16_t;
typedef short bf16x8 __attribute__((ext_vector_type(8)));
typedef short bf16x4 __attribute__((ext_vector_type(4)));
typedef float f32x4 __attribute__((ext_vector_type(4)));
typedef unsigned u32x4 __attribute__((ext_vector_type(4)));
typedef unsigned u32x2 __attribute__((ext_vector_type(2)));
#define LAS __attribute__((address_space(3)))
#define LDS_WAIT() asm volatile("s_waitcnt lgkmcnt(0)" ::: "memory")

__device__ __forceinline__ unsigned f2bf(float f) { unsigned u = __builtin_bit_cast(unsigned, f); return (u + 0x7fffu + ((u >> 16) & 1u)) >> 16; }
__device__ __forceinline__ unsigned pk2(float lo, float hi) { return pg8::cvt_pk_bf16(lo, hi); }
__device__ __forceinline__ float bf2f(unsigned short b) { return __builtin_bit_cast(float, (unsigned)b << 16); }
__device__ __forceinline__ float bflo(unsigned w) { return __builtin_bit_cast(float, w << 16); }
__device__ __forceinline__ float bfhi(unsigned w) { return __builtin_bit_cast(float, w & 0xffff0000u); }
__device__ __forceinline__ float wave_sum(float v) {
#pragma unroll
    for (int o = 1; o < 64; o <<= 1) v += __shfl_xor(v, o);
    return v;
}


#define XB_TMO      128
#define XB_XCNT(j)  (256  + 64 * (j))
#define XB_XSUB(j)  (1280 + 64 * (j))
#define XB_XGEN(j)  (2304 + 64 * (j))
#define XB_TOP      3328
#define XB_TOPGEN   3392
#define XCD_BAR_WORDS 3456
#define XB_SPIN_CAP (1u << 22)
__device__ __forceinline__ unsigned xb_ld(unsigned* p)              { return __hip_atomic_load(p, __ATOMIC_RELAXED, __HIP_MEMORY_SCOPE_AGENT); }
__device__ __forceinline__ unsigned xb_add(unsigned* p, unsigned v) { return __hip_atomic_fetch_add(p, v, __ATOMIC_RELAXED, __HIP_MEMORY_SCOPE_AGENT); }
__device__ __forceinline__ unsigned xb_xcc_id() { return (unsigned)__builtin_amdgcn_s_getreg((3 << 11) | 20) & 0xFu; }
#define XB_SPIN(cond, bar) do { unsigned _sp = 0; while (cond) { __builtin_amdgcn_s_sleep(1); \
    if ((++_sp & 255u) == 0u) { if (xb_ld(&(bar)[XB_TMO])) break; if (_sp > XB_SPIN_CAP) { atomicAdd(&(bar)[XB_TMO], 1u); break; } } } } while (0)
struct XcdBarrier { unsigned* bar; unsigned x; volatile LAS unsigned* st; };
__device__ __forceinline__ XcdBarrier xcd_barrier_post(unsigned* bar, volatile LAS unsigned* st) {
    XcdBarrier b; b.bar = bar; b.x = xb_xcc_id(); b.st = st;
    if (threadIdx.x == 0) (void)xb_add(&bar[XB_XCNT(b.x)], 1u);
    return b;
}
__device__ __forceinline__ void xcd_barrier_complete(unsigned* bar, unsigned x, unsigned& nloc, unsigned& nx) {
    const unsigned G = gridDim.x * gridDim.y * gridDim.z;
    unsigned sum, cnt, mine, sp = 0u;
    for (;;) {
        sum = 0u; cnt = 0u; mine = 0u;
#pragma unroll
        for (unsigned j = 0; j < 16; ++j) { const unsigned c = xb_ld(&bar[XB_XCNT(j)]); sum += c; cnt += (c > 0u) ? 1u : 0u; mine = (j == x) ? c : mine; }
        if (sum == G) break;
        __builtin_amdgcn_s_sleep(1);
        if ((++sp & 255u) == 0u) { if (xb_ld(&bar[XB_TMO])) break; if (sp > XB_SPIN_CAP) { atomicAdd(&bar[XB_TMO], 1u); break; } }
    }
    nloc = mine > 0u ? mine : 1u; nx = cnt > 0u ? cnt : 1u;
}
__device__ __forceinline__ void xcd_barrier(const XcdBarrier& b) {
    asm volatile("s_waitcnt vmcnt(0)" ::: "memory");
    __syncthreads();
    if (threadIdx.x == 0) {
        unsigned* bar = b.bar;
        __builtin_amdgcn_s_waitcnt(0);
        unsigned nloc = b.st[0], nx = b.st[1];
        if (nloc == 0u) { xcd_barrier_complete(bar, b.x, nloc, nx); b.st[0] = nloc; b.st[1] = nx; }
        const unsigned old = xb_add(&bar[XB_XSUB(b.x)], 1u);
        const unsigned gen = old / nloc;
        if (old + 1u == (gen + 1u) * nloc) {
            __builtin_amdgcn_fence(__ATOMIC_RELEASE, "agent");
            asm volatile("s_waitcnt vmcnt(0)" ::: "memory");
            const unsigned og = xb_add(&bar[XB_TOP], 1u);
            const unsigned tg = og / nx;
            if (og + 1u == (tg + 1u) * nx) xb_add(&bar[XB_TOPGEN], 1u);
            else XB_SPIN(xb_ld(&bar[XB_TOPGEN]) == tg, bar);
            __builtin_amdgcn_fence(__ATOMIC_ACQUIRE, "agent");
            xb_add(&bar[XB_XGEN(b.x)], 1u);
            asm volatile("s_waitcnt vmcnt(0)" ::: "memory");
        } else {
            XB_SPIN(xb_ld(&bar[XB_XGEN(b.x)]) == gen, bar);
            __builtin_amdgcn_fence(__ATOMIC_ACQUIRE, "agent");
            asm volatile("s_waitcnt vmcnt(0)" ::: "memory");
        }
    }
    __syncthreads();
}

struct Args { const float* in[22]; float* out; unsigned char* ws; int ph_lo, ph_hi; };
typedef const __attribute__((address_space(4))) Args* KA;
enum { I_X = 0, I_C, I_WADA, I_BADA, I_GF1, I_W1A, I_W3A, I_W2A, I_GMIX, I_WIN, I_SPW, I_SPB, I_GV, I_GQ, I_GK, I_SINKS, I_RELB, I_WOUT, I_GF2, I_W1B, I_W3B, I_W2B };


typedef _Float16 h16x4 __attribute__((ext_vector_type(4)));
typedef _Float16 h16x8 __attribute__((ext_vector_type(8)));
template <int MODE> struct EpiResidK {
    static constexpr bool PERM = true, AFTER_DRAIN = false; static constexpr int REP = (MODE == 2) ? MK_EPI_REP_OUT : 1;
    KA ka;
    __device__ __forceinline__ void prefetch(LAS unsigned char* sl, const pg8::Unit& u, int wr, int wc, int lane) const {
        KA k = ka; asm volatile("" : "+s"(k));
        const float* mod = (const float*)(k->ws + WS_MOD);
        const int col = u.pn * pg8::BM + wc * 32 + (lane & 31) + (lane >> 5) * pg8::HALF; const size_t bo = (size_t)(u.pm / (SEQ / 256)) * MODW;
        const float* gate = mod + (MODE == 0 ? 2 : MODE == 1 ? 5 : 8) * DM + bo + col;
        __builtin_amdgcn_global_load_lds((const unsigned*)gate, (LAS unsigned*)sl, 4, 0, 0);
        if constexpr (MODE != 2) {
            const float* g_next = k->in[MODE == 0 ? I_GMIX : I_GF2] + col; const float* sc_next = mod + (MODE == 0 ? 4 : 7) * DM + bo + col;
            __builtin_amdgcn_global_load_lds((const unsigned*)g_next, (LAS unsigned*)(sl + 256), 4, 0, 0);
            __builtin_amdgcn_global_load_lds((const unsigned*)sc_next, (LAS unsigned*)(sl + 512), 4, 0, 0);
        }
    }
    __device__ __forceinline__ void operator()(const pg8::f32x4 (&acc)[2][2][4][2], const pg8::Unit& u, int wr, int wc, int fr, int fq, LAS unsigned char* sl) const {
        using pg8::BM; using pg8::HALF; using pg8::cvt_pk_bf16;
        KA k = ka; asm volatile("" : "+s"(k));
        unsigned char* ws = k->ws;
        constexpr float scale = (MODE == 1) ? 1.0f : 0.5f;
        constexpr bool has_next = (MODE != 2);
        const float* xin = k->in[I_X]; _Float16* XH = (_Float16*)(ws + WS_XH); float* outf = k->out;
        bf16_t* An = (bf16_t*)(ws + WS_H); float* ssq_next = (float*)(ws + WS_SSQ) + (MODE == 0 ? M : 2 * M);
        constexpr int ldc = DM;
        const int col0 = u.pn * BM + wc * 32 + 8 * fq;
        const int rowb = u.pm * BM + wr * 64 + fr;
        constexpr int WIN = (MODE == 0) ? 2 : 4;
        f32x4 bsf[MODE == 0 ? WIN : 1][2][2]; h16x8 bsh[MODE == 0 ? 1 : WIN][2];
#define RES_LOAD(slot, rowidx) do { const size_t o_ = (size_t)(rowidx) * ldc + col0; \
        if constexpr (MODE == 0) { _Pragma("unroll") for (int bj = 0; bj < 2; ++bj) _Pragma("unroll") for (int n = 0; n < 2; ++n) bsf[slot][bj][n] = __builtin_nontemporal_load((const f32x4*)(xin + o_ + bj * HALF + n * 4)); } \
        else { _Pragma("unroll") for (int bj = 0; bj < 2; ++bj) bsh[slot][bj] = *(const h16x8*)(XH + o_ + bj * HALF); } } while (0)
#pragma unroll
        for (int gi = 0; gi < WIN; ++gi) RES_LOAD(gi, rowb + (gi >> 2) * HALF + (gi & 3) * 16);
        const LAS float* sf = (const LAS float*)sl;
        f32x4 gv[2][2], ca[2][2];
#pragma unroll
        for (int bj = 0; bj < 2; ++bj)
#pragma unroll
            for (int n = 0; n < 2; ++n) { gv[bj][n] = *(const LAS f32x4*)(sf + bj * 32 + 8 * fq + 4 * n) * scale;
                if constexpr (has_next) ca[bj][n] = *(const LAS f32x4*)(sf + 64 + bj * 32 + 8 * fq + 4 * n) * (*(const LAS f32x4*)(sf + 128 + bj * 32 + 8 * fq + 4 * n) + 1.0f);
                else ca[bj][n] = (f32x4){0.f, 0.f, 0.f, 0.f}; }
#pragma unroll
        for (int gi = 0; gi < 8; ++gi) { const int ai = gi >> 2, m = gi & 3;
            const int row = rowb + ai * HALF + m * 16; const size_t off = (size_t)row * ldc + col0;
            float sq = 0.f;
#pragma unroll
            for (int bj = 0; bj < 2; ++bj) { f32x4 o[2];
#pragma unroll
                for (int n = 0; n < 2; ++n) { f32x4 bv;
                    if constexpr (MODE == 0) bv = bsf[gi % WIN][bj][n];
                    else { const h16x8 hh = bsh[gi % WIN][bj]; bv = (f32x4){(float)hh[4 * n], (float)hh[4 * n + 1], (float)hh[4 * n + 2], (float)hh[4 * n + 3]}; }
                    o[n] = bv + gv[bj][n] * acc[ai][bj][m][n];
                    if constexpr (MODE == 2) *(f32x4*)(outf + off + bj * HALF + n * 4) = o[n];
                    sq += (o[n][0] * o[n][0] + o[n][1] * o[n][1]) + (o[n][2] * o[n][2] + o[n][3] * o[n][3]); }
                if constexpr (has_next) {
                    h16x8 xh;
#pragma unroll
                    for (int e = 0; e < 4; ++e) { xh[e] = (_Float16)o[0][e]; xh[4 + e] = (_Float16)o[1][e]; }
                    *(h16x8*)(XH + off + bj * HALF) = xh;
                    const f32x4 h0 = o[0] * ca[bj][0], h1 = o[1] * ca[bj][1];
                    u32x4 w; w.x = cvt_pk_bf16(h0[0], h0[1]); w.y = cvt_pk_bf16(h0[2], h0[3]); w.z = cvt_pk_bf16(h1[0], h1[1]); w.w = cvt_pk_bf16(h1[2], h1[3]);
                    *(u32x4*)(An + off + bj * HALF) = w; } }
            if constexpr (has_next) { sq += __shfl_xor(sq, 16); sq += __shfl_xor(sq, 32); if (fq == 0) atomicAdd(ssq_next + row, sq); }
            if (gi + WIN < 8) RES_LOAD(gi % WIN, rowb + ((gi + WIN) >> 2) * HALF + ((gi + WIN) & 3) * 16);
            asm volatile("" ::: "memory");
        }
#undef RES_LOAD
    }
};

__device__ __forceinline__ void conv_item(const float* W, int K, int N, bf16_t* WT, int kb, int n0, int dst_row0, LAS float* scr, int lane) {
    const int k0 = 64 * kb;
#pragma unroll 8
    for (int i = 0; i < 32; ++i) { const int kk = 2 * i + (lane >> 5); scr[kk * 33 + (lane & 31)] = __builtin_nontemporal_load(W + (size_t)(k0 + kk) * N + n0 + (lane & 31)); }
    LDS_WAIT(); asm volatile("" ::: "memory");
    const int c = lane & 7;
#pragma unroll
    for (int j = 0; j < 4; ++j) { const int n = (lane >> 3) + 8 * j; const LAS float* s = scr + (8 * c) * 33 + n;
        u32x4 o; o.x = pk2(s[0 * 33], s[1 * 33]); o.y = pk2(s[2 * 33], s[3 * 33]); o.z = pk2(s[4 * 33], s[5 * 33]); o.w = pk2(s[6 * 33], s[7 * 33]);
        *(u32x4*)(WT + (size_t)(dst_row0 + n) * K + k0 + 8 * c) = o; }
    LDS_WAIT(); asm volatile("" ::: "memory");
}
__device__ __forceinline__ void conv_dispatch(KA a, int it, LAS float* scr, int lane) {
    unsigned char* ws = a->ws;
    constexpr int I_FF = (DM / 64) * (DFF / 32);
    constexpr int I_DN = (DFF / 64) * (DM / 32);
    constexpr int I_IN = (DM / 64) * (INC / 32);
    constexpr int I_OUT = (DM / 64) * (DM / 32);
    int r = it;
#define CONV_LAYER(W1I, W3I, W2I, WS13, WS2) { \
        bf16_t* W13 = (bf16_t*)(ws + (WS13)); bf16_t* W2 = (bf16_t*)(ws + (WS2)); \
        if (r < I_FF) { const int nblk = DFF / 32, kb = r / nblk, n0 = (r % nblk) * 32; conv_item(a->in[W1I], DM, DFF, W13, kb, n0, (n0 >> 7) * 256 + (n0 & 127), scr, lane); return; } r -= I_FF; \
        if (r < I_FF) { const int nblk = DFF / 32, kb = r / nblk, n0 = (r % nblk) * 32; conv_item(a->in[W3I], DM, DFF, W13, kb, n0, (n0 >> 7) * 256 + 128 + (n0 & 127), scr, lane); return; } r -= I_FF; \
        if (r < I_DN) { const int nblk = DM / 32, kb = r / nblk, n0 = (r % nblk) * 32; conv_item(a->in[W2I], DFF, DM, W2, kb, n0, n0, scr, lane); return; } r -= I_DN; }
    CONV_LAYER(I_W1A, I_W3A, I_W2A, WS_W13A, WS_W2A)
    CONV_LAYER(I_W1B, I_W3B, I_W2B, WS_W13B, WS_W2B)
#undef CONV_LAYER
    if (r < I_IN) { const int nblk = INC / 32, kb = r / nblk, n0 = (r % nblk) * 32; conv_item(a->in[I_WIN], DM, INC, (bf16_t*)(ws + WS_WIN), kb, n0, n0, scr, lane); return; } r -= I_IN;
    if (r < I_OUT) { const int nblk = DM / 32, kb = r / nblk, n0 = (r % nblk) * 32; conv_item(a->in[I_WOUT], DM, DM, (bf16_t*)(ws + WS_WOUT), kb, n0, n0, scr, lane); return; }
}
constexpr int N_CONV_ITEMS = 6 * 5632 + 3328 + 2048;
constexpr int N_MODCG = MODW / 256;
constexpr int N_MOD_ITEMS = N_MODCG * NKC;

__device__ __forceinline__ void mod_item(KA a, int it, LAS float* scr, int lane) {
    const int cgp = it % N_MODCG, kc = it / N_MODCG, k0 = kc * KCH;
    const float* c = a->in[I_C];
    { const int kk = lane & 31, bh = lane >> 5;
#pragma unroll
      for (int bb = 0; bb < 2; ++bb) { const int b = bh * 2 + bb; const float v = c[b * DM + k0 + kk]; scr[b * 32 + kk] = v / (1.0f + __expf(-v)); } }
    LDS_WAIT(); asm volatile("" ::: "memory");
    const float* wp = a->in[I_WADA] + (size_t)k0 * MODW + cgp * 256 + lane * 4;
    f32x4 acc[4] = {{0.f, 0.f, 0.f, 0.f}, {0.f, 0.f, 0.f, 0.f}, {0.f, 0.f, 0.f, 0.f}, {0.f, 0.f, 0.f, 0.f}};
#pragma unroll 8
    for (int kk = 0; kk < KCH; ++kk) { const f32x4 w = __builtin_nontemporal_load((const f32x4*)(wp + (size_t)kk * MODW));
#pragma unroll
        for (int b = 0; b < 4; ++b) acc[b] += w * scr[b * 32 + kk]; }
    float* part = (float*)(a->ws + WS_PART);
#pragma unroll
    for (int b = 0; b < 4; ++b) *(f32x4*)(part + (size_t)(kc * 4 + b) * MODW + cgp * 256 + lane * 4) = acc[b];
    LDS_WAIT(); asm volatile("" ::: "memory");
}

__device__ __forceinline__ void prologue_pass(const float* X, const float* g, const float* mod, int sc_idx, bf16_t* H, float* ssq, int gw, int ngw, int lane) {
    const int rpw = M / ngw;
    const int row0 = gw * rpw, b = row0 / SEQ;
    const f32x4* g4 = (const f32x4*)g + lane; const f32x4* sc4 = (const f32x4*)(mod + (size_t)b * MODW + sc_idx * DM) + lane;
    f32x4 ca[8];
#pragma unroll
    for (int j = 0; j < 8; ++j) ca[j] = g4[64 * j] * (sc4[64 * j] + 1.0f);
    f32x4 vn[8];
    { const f32x4* xr = (const f32x4*)(X + (size_t)row0 * DM) + lane;
#pragma unroll
      for (int j = 0; j < 8; ++j) vn[j] = __builtin_nontemporal_load(xr + 64 * j); }
    for (int rr = 0; rr < rpw; ++rr) {
        const int row = row0 + rr;
        f32x4 v[8]; float s = 0.f;
#pragma unroll
        for (int j = 0; j < 8; ++j) v[j] = vn[j];
        { const f32x4* xr = (const f32x4*)(X + (size_t)(rr + 1 < rpw ? row + 1 : row) * DM) + lane;
#pragma unroll
          for (int j = 0; j < 8; ++j) vn[j] = __builtin_nontemporal_load(xr + 64 * j); }
#pragma unroll
        for (int j = 0; j < 8; ++j) s += (v[j].x * v[j].x + v[j].y * v[j].y) + (v[j].z * v[j].z + v[j].w * v[j].w);
        u32x2* o8 = (u32x2*)(H + (size_t)row * DM) + lane;
#pragma unroll
        for (int j = 0; j < 8; ++j) { const f32x4 h = v[j] * ca[j]; u32x2 w; w.x = pk2(h.x, h.y); w.y = pk2(h.z, h.w); o8[64 * j] = w; }
        s = wave_sum(s);
        if (lane == 0) ssq[row] = s;
    }
}
__device__ __forceinline__ void bias_gemv(const bf16_t* W, int N, const float* shift, float* out, int gw, int ngw, int lane) {
    f32x4 cb[4][4][2];
#pragma unroll
    for (int b = 0; b < 4; ++b)
#pragma unroll
        for (int j = 0; j < 4; ++j) { const float* p = shift + (size_t)b * MODW + 8 * (lane + 64 * j); cb[b][j][0] = *(const f32x4*)p; cb[b][j][1] = *(const f32x4*)(p + 4); }
    for (int n = gw; n < N; n += 2 * ngw) {
        const int n1 = n + ngw; const bool has1 = n1 < N;
        const u32x4* wp0 = (const u32x4*)(W + (size_t)n * DM) + lane; const u32x4* wp1 = (const u32x4*)(W + (size_t)(has1 ? n1 : n) * DM) + lane;
        u32x4 w[2][4];
#pragma unroll
        for (int j = 0; j < 4; ++j) { w[0][j] = wp0[64 * j]; w[1][j] = wp1[64 * j]; }
#pragma unroll
        for (int rr = 0; rr < 2; ++rr) {
            float acc[4] = {0.f, 0.f, 0.f, 0.f};
#pragma unroll
            for (int j = 0; j < 4; ++j) { const f32x4 w0 = (f32x4){bflo(w[rr][j].x), bfhi(w[rr][j].x), bflo(w[rr][j].y), bfhi(w[rr][j].y)}, w1 = (f32x4){bflo(w[rr][j].z), bfhi(w[rr][j].z), bflo(w[rr][j].w), bfhi(w[rr][j].w)};
#pragma unroll
                for (int b = 0; b < 4; ++b) { const f32x4 p = w0 * cb[b][j][0] + w1 * cb[b][j][1]; acc[b] += (p.x + p.y) + (p.z + p.w); } }
            const int nn = rr ? n1 : n;
#pragma unroll
            for (int b = 0; b < 4; ++b) { const float t = wave_sum(acc[b]); if (lane == 0 && (rr == 0 || has1)) out[(size_t)b * N + nn] = t; }
        }
    }
}

constexpr int GW_STR = 136;
__device__ __forceinline__ void gmlp_phase(KA a, LAS unsigned char* lds, int bid, int tid, int wid, int lane) {
    const int h = bid & 7;
    LAS bf16_t* Wl = (LAS bf16_t*)lds;
    LAS bf16_t* Vt = (LAS bf16_t*)(lds + 128 * GW_STR * 2);
    const bf16_t* Z = (const bf16_t*)(a->ws + WS_U); bf16_t* Y = (bf16_t*)(a->ws + WS_Y);
    const int r = lane & 15, q = lane >> 4;
    { const int i = tid >> 2, qd = tid & 3; const float* src = a->in[I_SPW] + ((size_t)h * 128 + i) * 128 + qd * 32;
#pragma unroll
      for (int k = 0; k < 4; ++k) { const f32x4 x0 = *(const f32x4*)(src + 8 * k), x1 = *(const f32x4*)(src + 8 * k + 4); const int j0 = qd * 32 + 8 * k;
          float e[8] = {x0.x, x0.y, x0.z, x0.w, x1.x, x1.y, x1.z, x1.w};
#pragma unroll
          for (int t = 0; t < 8; ++t) e[t] = (j0 + t <= i) ? e[t] : 0.f;
          u32x4 o; o.x = pk2(e[0], e[1]); o.y = pk2(e[2], e[3]); o.z = pk2(e[4], e[5]); o.w = pk2(e[6], e[7]);
          *(LAS u32x4*)(Wl + i * GW_STR + j0) = o; } }
    const int sj = tid >> 2, sqd = tid & 3;
    const int gi_ = 16 * wid + r; const float sb = a->in[I_SPB][h * 128 + gi_];
    float gvr[32];
#pragma unroll
    for (int e = 0; e < 32; ++e) gvr[e] = a->in[I_GV][h * 128 + sqd * 32 + e];
    u32x4 raw[4]; u32x2 ur[8];
    { const int combo = (bid >> 3); const size_t R0 = (size_t)(combo >> 6) * SEQ + (size_t)(combo & 63) * 128;
      const bf16_t* src = Z + (R0 + sj) * INC + AW + h * 128 + sqd * 32;
#pragma unroll
      for (int k = 0; k < 4; ++k) raw[k] = *(const u32x4*)(src + 8 * k);
      const bf16_t* up = Z + (R0 + gi_) * INC + h * 128 + 4 * q;
#pragma unroll
      for (int dt = 0; dt < 8; ++dt) ur[dt] = *(const u32x2*)(up + 16 * dt); }
    for (int it = 0; it < 8; ++it) {
        const int combo = (bid >> 3) + 32 * it; const size_t R0 = (size_t)(combo >> 6) * SEQ + (size_t)(combo & 63) * 128;
        const int combo1 = (bid >> 3) + 32 * (it < 7 ? it + 1 : it); const size_t R1 = (size_t)(combo1 >> 6) * SEQ + (size_t)(combo1 & 63) * 128;
        __syncthreads();
        { float v[32]; float ss = 0.f;
#pragma unroll
          for (int k = 0; k < 4; ++k) { v[8 * k + 0] = bflo(raw[k].x); v[8 * k + 1] = bfhi(raw[k].x); v[8 * k + 2] = bflo(raw[k].y); v[8 * k + 3] = bfhi(raw[k].y);
              v[8 * k + 4] = bflo(raw[k].z); v[8 * k + 5] = bfhi(raw[k].z); v[8 * k + 6] = bflo(raw[k].w); v[8 * k + 7] = bfhi(raw[k].w); }
          { const bf16_t* src = Z + (R1 + sj) * INC + AW + h * 128 + sqd * 32;
#pragma unroll
            for (int k = 0; k < 4; ++k) raw[k] = *(const u32x4*)(src + 8 * k); }
#pragma unroll
          for (int e = 0; e < 32; ++e) ss += v[e] * v[e];
          ss += __shfl_xor(ss, 1); ss += __shfl_xor(ss, 2);
          const float rstd = 1.0f / sqrtf(ss * (1.0f / 128.0f) + EPS);
#pragma unroll
          for (int e = 0; e < 32; ++e) Vt[(sqd * 32 + e) * GW_STR + sj] = (bf16_t)f2bf(v[e] * rstd * gvr[e]); }
        __syncthreads();
        f32x4 acc[8];
#pragma unroll
        for (int dt = 0; dt < 8; ++dt) acc[dt] = (f32x4){0.f, 0.f, 0.f, 0.f};
        const int nks = (wid >> 1) + 1;
        for (int ks = 0; ks < nks; ++ks) {
            const bf16x8 bfr = *(const LAS bf16x8*)(Wl + (16 * wid + r) * GW_STR + 32 * ks + 8 * q);
#pragma unroll
            for (int dt = 0; dt < 8; ++dt) { const bf16x8 afr = *(const LAS bf16x8*)(Vt + (16 * dt + r) * GW_STR + 32 * ks + 8 * q);
                acc[dt] = __builtin_amdgcn_mfma_f32_16x16x32_bf16(afr, bfr, acc[dt], 0, 0, 0); }
        }
        bf16_t* yp = Y + (R0 + gi_) * DM + h * 128 + 4 * q;
#pragma unroll
        for (int dt = 0; dt < 8; ++dt) { const u32x2 uu = ur[dt];
            u32x2 o; o.x = pk2(bflo(uu.x) * (acc[dt][0] + sb), bfhi(uu.x) * (acc[dt][1] + sb)); o.y = pk2(bflo(uu.y) * (acc[dt][2] + sb), bfhi(uu.y) * (acc[dt][3] + sb));
            *(u32x2*)(yp + 16 * dt) = o; }
        { const bf16_t* up = Z + (R1 + gi_) * INC + h * 128 + 4 * q;
#pragma unroll
          for (int dt = 0; dt < 8; ++dt) ur[dt] = *(const u32x2*)(up + 16 * dt); }
    }
}

constexpr int KL_STR = 72, VT_STR = 264;
__device__ __forceinline__ int t5_bucket(int n) { if (n < 16) return n; const float v = logf((float)n * (1.0f / 16.0f)) / 2.0794415416798357f * 16.0f; const int l = 16 + (int)v; return l < 31 ? l : 31; }
__device__ __forceinline__ void attn_phase(KA a, LAS unsigned char* lds, int bid, int nblk, int tid, int wid, int lane) {
    LAS bf16_t* Kl = (LAS bf16_t*)lds;
    LAS bf16_t* Vt = (LAS bf16_t*)(lds + 256 * KL_STR * 2);
    LAS float* tb = (LAS float*)(lds + 256 * KL_STR * 2 + 64 * VT_STR * 2);
    const bf16_t* Z = (const bf16_t*)(a->ws + WS_U); bf16_t* Y = (bf16_t*)(a->ws + WS_Y);
    const int r = lane & 15, q = lane >> 4;
    const float NEG = -__builtin_inff();
    constexpr float SC = 0.125f * LOG2E;
    for (int unit = bid; unit < 512; unit += nblk) {
        const int kvh = unit & 1, combo = unit >> 1, b = combo >> 6, nb = combo & 63; const size_t R0 = (size_t)b * SEQ + (size_t)nb * 128;
        __syncthreads();
        { const int key = tid >> 1, half = tid & 1; const bool valid = (nb > 0) || (key >= 128);
          u32x4 kr[4], vr[4];
          if (valid) { const bf16_t* kp = Z + (R0 - 128 + key) * INC + 3072 + kvh * 64 + half * 32; const bf16_t* vp = kp + 128;
#pragma unroll
              for (int k = 0; k < 4; ++k) { kr[k] = *(const u32x4*)(kp + 8 * k); vr[k] = *(const u32x4*)(vp + 8 * k); } }
          else {
#pragma unroll
              for (int k = 0; k < 4; ++k) { kr[k] = (u32x4){0u, 0u, 0u, 0u}; vr[k] = (u32x4){0u, 0u, 0u, 0u}; } }
          float kv[32]; float ss = 0.f;
#pragma unroll
          for (int k = 0; k < 4; ++k) { kv[8 * k + 0] = bflo(kr[k].x); kv[8 * k + 1] = bfhi(kr[k].x); kv[8 * k + 2] = bflo(kr[k].y); kv[8 * k + 3] = bfhi(kr[k].y);
              kv[8 * k + 4] = bflo(kr[k].z); kv[8 * k + 5] = bfhi(kr[k].z); kv[8 * k + 6] = bflo(kr[k].w); kv[8 * k + 7] = bfhi(kr[k].w); }
#pragma unroll
          for (int e = 0; e < 32; ++e) ss += kv[e] * kv[e];
          ss += __shfl_xor(ss, 1);
          const float rstd = 1.0f / sqrtf(ss * (1.0f / 64.0f) + EPS);
          const float* gk = a->in[I_GK] + half * 32;
#pragma unroll
          for (int k = 0; k < 4; ++k) { u32x4 o; o.x = pk2(kv[8 * k] * rstd * gk[8 * k], kv[8 * k + 1] * rstd * gk[8 * k + 1]); o.y = pk2(kv[8 * k + 2] * rstd * gk[8 * k + 2], kv[8 * k + 3] * rstd * gk[8 * k + 3]);
              o.z = pk2(kv[8 * k + 4] * rstd * gk[8 * k + 4], kv[8 * k + 5] * rstd * gk[8 * k + 5]); o.w = pk2(kv[8 * k + 6] * rstd * gk[8 * k + 6], kv[8 * k + 7] * rstd * gk[8 * k + 7]);
              *(LAS u32x4*)(Kl + key * KL_STR + half * 32 + 8 * k) = o; }
#pragma unroll
          for (int k = 0; k < 4; ++k) { const unsigned w4[4] = {vr[k].x, vr[k].y, vr[k].z, vr[k].w};
#pragma unroll
              for (int t = 0; t < 4; ++t) { Vt[(half * 32 + 8 * k + 2 * t) * VT_STR + key] = (bf16_t)(w4[t] & 0xffffu); Vt[(half * 32 + 8 * k + 2 * t + 1) * VT_STR + key] = (bf16_t)(w4[t] >> 16); } }
        }
        for (int idx = tid; idx < 1024; idx += NTHREADS) { const int g = idx >> 7, dist = idx & 127; tb[idx] = a->in[I_RELB][t5_bucket(dist) * 16 + kvh * 8 + g] * LOG2E; }
        __syncthreads();
        const int hq = kvh * 8 + wid;
        float breg[9][4];
#pragma unroll
        for (int t = 0; t < 9; ++t)
#pragma unroll
            for (int e = 0; e < 4; ++e) { const int dist = r + 128 - 16 * t - 4 * q - e; breg[t][e] = (dist >= 0 && dist < 128) ? tb[wid * 128 + (dist & 127)] : NEG; }
        const float sink2 = a->in[I_SINKS][hq] * LOG2E;
        float gq[2][8];
#pragma unroll
        for (int ks = 0; ks < 2; ++ks)
#pragma unroll
            for (int e = 0; e < 8; ++e) gq[ks][e] = a->in[I_GQ][32 * ks + 8 * q + e];
        u32x4 qn0, qn1;
        { const bf16_t* qp = Z + (R0 + r) * INC + 2 * AW + hq * 64 + 8 * q; qn0 = *(const u32x4*)qp; qn1 = *(const u32x4*)(qp + 32); }
        for (int c = 0; c < 8; ++c) {
            const u32x4 q0 = qn0, q1 = qn1;
            { const bf16_t* qp = Z + (R0 + 16 * (c < 7 ? c + 1 : c) + r) * INC + 2 * AW + hq * 64 + 8 * q; qn0 = *(const u32x4*)qp; qn1 = *(const u32x4*)(qp + 32); }
            float qv[2][8] = {{bflo(q0.x), bfhi(q0.x), bflo(q0.y), bfhi(q0.y), bflo(q0.z), bfhi(q0.z), bflo(q0.w), bfhi(q0.w)},
                              {bflo(q1.x), bfhi(q1.x), bflo(q1.y), bfhi(q1.y), bflo(q1.z), bfhi(q1.z), bflo(q1.w), bfhi(q1.w)}};
            float ss = 0.f;
#pragma unroll
            for (int ks = 0; ks < 2; ++ks)
#pragma unroll
                for (int e = 0; e < 8; ++e) ss += qv[ks][e] * qv[ks][e];
            ss += __shfl_xor(ss, 16); ss += __shfl_xor(ss, 32);
            const float rstd = 1.0f / sqrtf(ss * (1.0f / 64.0f) + EPS);
            bf16x8 qf[2];
#pragma unroll
            for (int ks = 0; ks < 2; ++ks) { u32x4 o; o.x = pk2(qv[ks][0] * rstd * gq[ks][0], qv[ks][1] * rstd * gq[ks][1]); o.y = pk2(qv[ks][2] * rstd * gq[ks][2], qv[ks][3] * rstd * gq[ks][3]);
                o.z = pk2(qv[ks][4] * rstd * gq[ks][4], qv[ks][5] * rstd * gq[ks][5]); o.w = pk2(qv[ks][6] * rstd * gq[ks][6], qv[ks][7] * rstd * gq[ks][7]); qf[ks] = __builtin_bit_cast(bf16x8, o); }
            f32x4 sacc[9];
#pragma unroll
            for (int t = 0; t < 9; ++t) { sacc[t] = (f32x4){0.f, 0.f, 0.f, 0.f};
#pragma unroll
                for (int ks = 0; ks < 2; ++ks) { const bf16x8 kf = *(const LAS bf16x8*)(Kl + (16 * (c + t) + r) * KL_STR + 32 * ks + 8 * q);
                    sacc[t] = __builtin_amdgcn_mfma_f32_16x16x32_bf16(kf, qf[ks], sacc[t], 0, 0, 0); } }
            float mx = sink2;
#pragma unroll
            for (int t = 0; t < 9; ++t) { const bool dead = (nb == 0) && (c + t < 8);
#pragma unroll
                for (int e = 0; e < 4; ++e) { float s = sacc[t][e] * SC + breg[t][e]; s = dead ? NEG : s; sacc[t][e] = s; mx = fmaxf(mx, s); } }
            mx = fmaxf(mx, __shfl_xor(mx, 16)); mx = fmaxf(mx, __shfl_xor(mx, 32));
            float l = 0.f;
#pragma unroll
            for (int t = 0; t < 9; ++t)
#pragma unroll
                for (int e = 0; e < 4; ++e) { const float p = __builtin_amdgcn_exp2f(sacc[t][e] - mx); sacc[t][e] = p; l += p; }
            l += __shfl_xor(l, 16); l += __shfl_xor(l, 32);
            l += __builtin_amdgcn_exp2f(sink2 - mx);
            const float inv = 1.0f / l;
            f32x4 o[4];
#pragma unroll
            for (int dt = 0; dt < 4; ++dt) o[dt] = (f32x4){0.f, 0.f, 0.f, 0.f};
#pragma unroll
            for (int kk = 0; kk < 5; ++kk) {
                u32x4 pw; pw.x = pk2(sacc[2 * kk][0], sacc[2 * kk][1]); pw.y = pk2(sacc[2 * kk][2], sacc[2 * kk][3]);
                if (kk < 4) { pw.z = pk2(sacc[(2 * kk + 1) % 9][0], sacc[(2 * kk + 1) % 9][1]); pw.w = pk2(sacc[(2 * kk + 1) % 9][2], sacc[(2 * kk + 1) % 9][3]); } else { pw.z = 0u; pw.w = 0u; }
                const bf16x8 pf = __builtin_bit_cast(bf16x8, pw);
#pragma unroll
                for (int dt = 0; dt < 4; ++dt) { const LAS bf16_t* vp = Vt + (16 * dt + r) * VT_STR + 16 * (c + 2 * kk) + 4 * q;
                    u32x4 av; const u32x2 lo = *(const LAS u32x2*)vp; av.x = lo.x; av.y = lo.y;
                    if (kk < 4) { const u32x2 hi = *(const LAS u32x2*)(vp + 16); av.z = hi.x; av.w = hi.y; } else { av.z = 0u; av.w = 0u; }
                    o[dt] = __builtin_amdgcn_mfma_f32_16x16x32_bf16(__builtin_bit_cast(bf16x8, av), pf, o[dt], 0, 0, 0); }
            }
            bf16_t* yp = Y + (R0 + 16 * c + r) * DM + AW + hq * 64 + 4 * q;
#pragma unroll
            for (int dt = 0; dt < 4; ++dt) { u32x2 w; w.x = pk2(o[dt][0] * inv, o[dt][1] * inv); w.y = pk2(o[dt][2] * inv, o[dt][3] * inv); *(u32x2*)(yp + 16 * dt) = w; }
        }
    }
}

static constexpr int SCHED_HOST[] = {MK_SCHED};
constexpr int NPH = (int)(sizeof(SCHED_HOST) / sizeof(int));
__global__ void __launch_bounds__(NTHREADS, 2) fwd_megakernel(Args args) {
    extern __shared__ __attribute__((aligned(16))) unsigned char lds_raw[];
    LAS unsigned char* lds = (LAS unsigned char*)lds_raw;
    KA ka0 = (KA)__builtin_amdgcn_kernarg_segment_ptr();
    const int ph_lo = ka0->ph_lo, ph_hi = ka0->ph_hi;
    const int wid0 = __builtin_amdgcn_readfirstlane(threadIdx.x >> 6);
    volatile LAS unsigned* misc = (volatile LAS unsigned*)(lds + 131072);
    if (threadIdx.x < 64) misc[threadIdx.x] = 0u;
    if (blockIdx.x == 0 && ph_lo == 0) { unsigned* bw = (unsigned*)(ka0->ws + WS_BAR); for (int i = threadIdx.x; i < XCD_BAR_WORDS; i += NTHREADS) bw[i] = 0u; }
    __syncthreads();
    XcdBarrier xbar; xbar.bar = (unsigned*)(ka0->ws + WS_BAR); xbar.x = 0; xbar.st = misc;
    bool xbar_posted = false;
    static constexpr int SCHED[] = {MK_SCHED};
    constexpr int NS = (int)(sizeof(SCHED) / sizeof(int));
    for (int si = ph_lo; si < ph_hi; ++si) {
        const int ph = SCHED[si];
        KA ka = ka0; asm volatile("" : "+s"(ka));
        int wid_s = wid0; asm volatile("" : "+s"(wid_s));
        int tid = wid_s * 64 + (int)__builtin_amdgcn_mbcnt_hi(~0u, __builtin_amdgcn_mbcnt_lo(~0u, 0u)); asm volatile("" : "+v"(tid));
        int bid = blockIdx.x, G = gridDim.x; asm volatile("" : "+s"(bid), "+s"(G));
        const int lane = tid & 63, wid = __builtin_amdgcn_readfirstlane(tid >> 6);
        const int gw = bid * NWAVES + wid, ngw = G * NWAVES;
        unsigned char* ws = ka->ws;
        float* mod = (float*)(ws + WS_MOD);
        bf16_t* H = (bf16_t*)(ws + WS_H); bf16_t* Y = (bf16_t*)(ws + WS_Y); bf16_t* U = (bf16_t*)(ws + WS_U);
        switch (ph) {
        case 0: {
            LAS float* scr = (LAS float*)(lds + wid * 16384);
            for (int it = gw; it < N_CONV_ITEMS + N_MOD_ITEMS; it += ngw) {
                if (it < N_MOD_ITEMS) mod_item(ka, it, scr, lane); else conv_dispatch(ka, it - N_MOD_ITEMS, scr, lane);
            }
        } break;
        case 1: {
            const float* part = (const float*)(ws + WS_PART); const float* bada = ka->in[I_BADA];
            for (int o = bid * NTHREADS + tid; o < BATCH * MODW; o += G * NTHREADS) { const int b = o / MODW, n = o % MODW; float s = bada[n];
#pragma unroll 8
                for (int kc = 0; kc < NKC; ++kc) s += part[(size_t)(kc * 4 + b) * MODW + n];
                mod[o] = s; }
        } break;
        case 2: {
            float* ssq = (float*)(ws + WS_SSQ); float* b2 = (float*)(ws + WS_B2);
            prologue_pass(ka->in[I_X], ka->in[I_GF1], mod, 1, H, ssq, gw, ngw, lane);
            bias_gemv((const bf16_t*)(ws + WS_W13A), 2 * DFF, mod + 0 * DM, b2, gw, ngw, lane);
            bias_gemv((const bf16_t*)(ws + WS_WIN), INC, mod + 3 * DM, b2 + 4 * 2 * DFF, gw, ngw, lane);
            bias_gemv((const bf16_t*)(ws + WS_W13B), 2 * DFF, mod + 6 * DM, b2 + 4 * 2 * DFF + 4 * INC, gw, ngw, lane);
            for (int i = bid * NTHREADS + tid; i < 2 * M; i += G * NTHREADS) ssq[M + i] = 0.f;
        } break;
        case 3: case 10: {
            const bool first = (ph == 3);
            pg8::Gemm g{H, (const bf16_t*)(ws + (first ? WS_W13A : WS_W13B)), M, 2 * DFF, DM}; pg8::StaticOrder S; S.init(M, 2 * DFF, G, bid);
            pg8::EpiSwiGLU E{U, DFF, (const float*)(ws + WS_SSQ) + (first ? 0 : 2 * M), (const float*)(ws + WS_B2) + (first ? 0 : 4 * 2 * DFF + 4 * INC), 2 * DFF, SEQ / 256};
            pg8::gemm_phase<pg8::EpiSwiGLU, pg8::StaticOrder, true, true>(lds, g, S, E, tid);
        } break;
        case 4: {
            pg8::Gemm g{U, (const bf16_t*)(ws + WS_W2A), M, DM, DFF}; pg8::StaticOrder S; S.init(M, DM, G, bid);
            EpiResidK<0> E{ka0};
            pg8::gemm_phase<EpiResidK<0>, pg8::StaticOrder, true, true>(lds, g, S, E, tid);
        } break;
        case 8: {
            pg8::Gemm g{Y, (const bf16_t*)(ws + WS_WOUT), M, DM, DM}; pg8::StaticOrder S; S.init(M, DM, G, bid);
            EpiResidK<1> E{ka0};
            pg8::gemm_phase<EpiResidK<1>, pg8::StaticOrder, true, true>(lds, g, S, E, tid);
        } break;
        case 11: {
            pg8::Gemm g{U, (const bf16_t*)(ws + WS_W2B), M, DM, DFF}; pg8::StaticOrder S; S.init(M, DM, G, bid);
            EpiResidK<2> E{ka0};
            pg8::gemm_phase<EpiResidK<2>, pg8::StaticOrder, true, true>(lds, g, S, E, tid);
        } break;
        case 6: {
            pg8::Gemm g{H, (const bf16_t*)(ws + WS_WIN), M, INC, DM}; pg8::StaticOrder S; S.init(M, INC, G, bid, 8);
            pg8::EpiZ E{U, INC, 8, (const float*)(ws + WS_SSQ) + M, (const float*)(ws + WS_B2) + 4 * 2 * DFF, INC, SEQ / 256};
            pg8::gemm_phase<pg8::EpiZ, pg8::StaticOrder, true, true>(lds, g, S, E, tid);
        } break;
        case 7: {
            gmlp_phase(ka, lds, bid, tid, wid, lane);
            attn_phase(ka, lds, bid, G, tid, wid, lane);
        } break;
        default: break;
        }
        if (si + 1 < ph_hi) {
            for (int rep = 0; rep < MK_SYNC_REPEAT; ++rep) {
                if (!xbar_posted) { cg::this_grid().sync(); xbar = xcd_barrier_post((unsigned*)(ka0->ws + WS_BAR), misc); xbar_posted = true; }
                else xcd_barrier(xbar);
            }
        }
    }
}

extern "C" void kernel_launch(void* const* d_in, const int* in_sizes, int n_in, void* d_out, int out_size, void* d_ws, size_t ws_size, hipStream_t stream) {
    static int grid = 0;
    if (grid == 0) {
        if (n_in != 22 || out_size != M * DM || ws_size < WS_END) { fprintf(stderr, "kernel_launch: unexpected shapes (n_in %d out %d ws %zu)\n", n_in, out_size, ws_size); grid = -1; return; }
        int dev = 0, cus = 0, per_cu = 0;
        (void)hipGetDevice(&dev); (void)hipDeviceGetAttribute(&cus, hipDeviceAttributeMultiprocessorCount, dev);
        if (hipFuncSetAttribute((const void*)fwd_megakernel, hipFuncAttributeMaxDynamicSharedMemorySize, LDS_BYTES) != hipSuccess) { fprintf(stderr, "kernel_launch: hipFuncSetAttribute failed\n"); grid = -1; return; }
        if (hipOccupancyMaxActiveBlocksPerMultiprocessor(&per_cu, (const void*)fwd_megakernel, NTHREADS, LDS_BYTES) != hipSuccess || per_cu < 1) { fprintf(stderr, "kernel_launch: occupancy query says %d\n", per_cu); per_cu = 1; }
        (void)hipGetLastError();
        grid = cus;
        if (grid != 256) fprintf(stderr, "kernel_launch: %d CUs (built for 256)\n", grid);
    }
    if (grid < 0) return;
    Args a{};
    for (int i = 0; i < 22; ++i) a.in[i] = (const float*)d_in[i];
    a.out = (float*)d_out; a.ws = (unsigned char*)d_ws;
#if MK_PER_PHASE
    for (int p = 0; p < NPH; ++p) { a.ph_lo = p; a.ph_hi = p + 1; hipLaunchKernelGGL(fwd_megakernel, dim3(grid), dim3(NTHREADS), LDS_BYTES, stream, a); }
#else
    a.ph_lo = 0; a.ph_hi = NPH;
    void* kargs[] = {(void*)&a};
    hipError_t e = hipLaunchCooperativeKernel((const void*)fwd_megakernel, dim3(grid), dim3(NTHREADS), kargs, LDS_BYTES, stream);
    if (e != hipSuccess) fprintf(stderr, "kernel_launch: cooperative launch failed: %s (grid %d)\n", hipGetErrorString(e), grid);
#endif
}
```
